# Optimizing an MI355X kernel written in HIP

```python
import math
import jax, jax.numpy as jnp
from jax import lax
import numpy as np

D_MODEL = 1024
BATCH = 2
SEQ = 8192
DEPTH = 2

MEM_TOKENS = 256
ROPE_THETA = 10000.0
RMS_EPS = 1e-6
Q_BLOCK = 128
NEG_INF = -1e30

MLA_HEADS = 8
Q_LORA = 256
KV_LORA = 128
MLA_NOPE = 64
MLA_ROPE = 32
MLA_QK = MLA_NOPE + MLA_ROPE
MLA_V = 64
MLA_W = MLA_HEADS * MLA_V

DIFF_HEADS = 4
DIFF_D = 32
DIFF_V = 2 * DIFF_D
DIFF_W = DIFF_HEADS * DIFF_V

MEM_HEADS = 4
MEM_D = 64
MEM_W = MEM_HEADS * MEM_D

D_MIX = MLA_W + DIFF_W + MEM_W

IN_SPLITS = [
    Q_LORA,
    KV_LORA,
    MLA_ROPE,
    DIFF_HEADS * 2 * DIFF_D,
    DIFF_HEADS * 2 * DIFF_D,
    DIFF_W,
    MEM_W,
    D_MIX,
]
D_IN = int(sum(IN_SPLITS))
IN_OFFSETS = [int(v) for v in np.cumsum(IN_SPLITS)[:-1]]

kernel_name = "hymba_mla_diffattn_memory_block"


def rms_norm(x, g, eps=RMS_EPS):
    xf = x.astype(jnp.float32)
    y = xf * lax.rsqrt(jnp.mean(xf * xf, axis=-1, keepdims=True) + eps)
    return (y * g.astype(jnp.float32)).astype(x.dtype)


def rope(x, pos):
    d = x.shape[-1]
    inv = ROPE_THETA ** (-jnp.arange(0, d, 2, dtype=jnp.float32) / d)
    ang = pos.astype(jnp.float32)[..., None] * inv
    cos = jnp.cos(ang)[:, :, None, :]
    sin = jnp.sin(ang)[:, :, None, :]
    xf = x.astype(jnp.float32)
    x1, x2 = xf[..., : d // 2], xf[..., d // 2:]
    out = jnp.concatenate([x1 * cos - x2 * sin, x2 * cos + x1 * sin], axis=-1)
    return out.astype(x.dtype)


def causal_mask(start, s_len):
    q_idx = start + jnp.arange(Q_BLOCK, dtype=jnp.int32)
    return jnp.arange(s_len, dtype=jnp.int32)[None, :] <= q_idx[:, None]


def causal_block_sweep(block_fn, q):
    b, s = q.shape[0], q.shape[1]
    nb = s // Q_BLOCK
    qb = jnp.moveaxis(q.reshape((b, nb, Q_BLOCK) + q.shape[2:]), 1, 0)
    starts = jnp.arange(nb, dtype=jnp.int32) * Q_BLOCK
    out = lax.map(lambda a: block_fn(a[0], a[1]), (qb, starts))
    return jnp.moveaxis(out, 0, 1).reshape((b, s) + out.shape[3:])


def mla_branch(cq, ckv, kr, pos, q_norm_g, kv_norm_g, w_uq, w_ukv, qn_g, kn_g):
    b, s, _ = cq.shape
    q = (rms_norm(cq, q_norm_g) @ w_uq).reshape(b, s, MLA_HEADS, MLA_QK)
    kv = (rms_norm(ckv, kv_norm_g) @ w_ukv).reshape(b, s, MLA_HEADS, MLA_NOPE + MLA_V)
    k_nope, v = kv[..., :MLA_NOPE], kv[..., MLA_NOPE:]
    k_rope = jnp.broadcast_to(kr.reshape(b, s, 1, MLA_ROPE), (b, s, MLA_HEADS, MLA_ROPE))
    k = jnp.concatenate([k_nope, k_rope], axis=-1)
    q = rms_norm(q, qn_g)
    k = rms_norm(k, kn_g)
    q = jnp.concatenate([q[..., :MLA_NOPE], rope(q[..., MLA_NOPE:], pos)], axis=-1)
    k = jnp.concatenate([k[..., :MLA_NOPE], rope(k[..., MLA_NOPE:], pos)], axis=-1)
    scale = 1.0 / math.sqrt(MLA_QK)

    def block_fn(qblk, start):
        sc = jnp.einsum('bqhd,bkhd->bhqk', qblk, k).astype(jnp.float32) * scale
        sc = jnp.where(causal_mask(start, s)[None, None], sc, NEG_INF)
        p = jax.nn.softmax(sc, axis=-1).astype(v.dtype)
        return jnp.einsum('bhqk,bkhd->bqhd', p, v)

    o = causal_block_sweep(block_fn, q)
    return o.reshape(b, s, MLA_W)


def diff_branch(dq, dk, dv, pos, qn_g, kn_g, lam_vecs, subln_g, lam_init):
    b, s, _ = dq.shape
    q = rms_norm(dq.reshape(b, s, DIFF_HEADS * 2, DIFF_D), qn_g)
    k = rms_norm(dk.reshape(b, s, DIFF_HEADS * 2, DIFF_D), kn_g)
    q = rope(q, pos).reshape(b, s, DIFF_HEADS, 2, DIFF_D)
    k = rope(k, pos).reshape(b, s, DIFF_HEADS, 2, DIFF_D)
    v = dv.reshape(b, s, DIFF_HEADS, DIFF_V)
    lv = lam_vecs.astype(jnp.float32)
    lam = jnp.exp(jnp.sum(lv[0] * lv[1])) - jnp.exp(jnp.sum(lv[2] * lv[3])) + lam_init
    scale = 1.0 / math.sqrt(DIFF_D)

    def block_fn(qblk, start):
        sc = jnp.einsum('bqhmd,bkhmd->bhmqk', qblk, k).astype(jnp.float32) * scale
        sc = jnp.where(causal_mask(start, s)[None, None, None], sc, NEG_INF)
        p = jax.nn.softmax(sc, axis=-1)
        a = (p[:, :, 0] - lam * p[:, :, 1]).astype(v.dtype)
        return jnp.einsum('bhqk,bkhd->bqhd', a, v)

    o = causal_block_sweep(block_fn, q)
    o = rms_norm(o, subln_g) * (1.0 - lam_init)
    return o.reshape(b, s, DIFF_W)


def mem_branch(mq, mem, mem_norm_g, w_mem_kv, qn_g, kn_g):
    b, s, _ = mq.shape
    m = mem.shape[1]
    kv = rms_norm(mem, mem_norm_g) @ w_mem_kv
    k = rms_norm(kv[..., :MEM_W].reshape(b, m, MEM_HEADS, MEM_D), kn_g)
    v = kv[..., MEM_W:].reshape(b, m, MEM_HEADS, MEM_D)
    q = rms_norm(mq.reshape(b, s, MEM_HEADS, MEM_D), qn_g)
    sc = jnp.einsum('bshd,bmhd->bhsm', q, k).astype(jnp.float32) / math.sqrt(MEM_D)
    p = jax.nn.softmax(sc, axis=-1).astype(v.dtype)
    o = jnp.einsum('bhsm,bmhd->bshd', p, v)
    return o.reshape(b, s, MEM_W)


def setup_inputs(seed: int = 0) -> dict:
    key = jax.random.key(seed)
    ks = jax.random.split(key, 24)
    f32 = jnp.float32

    def nrm(k, shape, fan_in):
        return jax.random.normal(k, shape, f32) * (fan_in ** -0.5)

    def gain(k, shape):
        return 1.0 + 0.01 * jax.random.normal(k, shape, f32)

    x = jax.random.normal(ks[0], (BATCH, SEQ, D_MODEL), f32)
    mem = jax.random.normal(ks[1], (BATCH, MEM_TOKENS, D_MODEL), f32)
    offsets = jax.random.randint(ks[2], (BATCH, 1), 0, 4096, dtype=jnp.int32)
    positions = offsets + jnp.arange(SEQ, dtype=jnp.int32)[None, :]
    return {
        "x": x,
        "mem": mem,
        "positions": positions,
        "norm_g": gain(ks[3], (DEPTH, D_MODEL)),
        "w_in": nrm(ks[4], (DEPTH, D_MODEL, D_IN), D_MODEL),
        "mla_q_norm_g": gain(ks[5], (DEPTH, Q_LORA)),
        "mla_kv_norm_g": gain(ks[6], (DEPTH, KV_LORA)),
        "w_uq": nrm(ks[7], (DEPTH, Q_LORA, MLA_HEADS * MLA_QK), Q_LORA),
        "w_ukv": nrm(ks[8], (DEPTH, KV_LORA, MLA_HEADS * (MLA_NOPE + MLA_V)), KV_LORA),
        "mla_qn_g": gain(ks[9], (DEPTH, MLA_QK)),
        "mla_kn_g": gain(ks[10], (DEPTH, MLA_QK)),
        "diff_qn_g": gain(ks[11], (DEPTH, DIFF_D)),
        "diff_kn_g": gain(ks[12], (DEPTH, DIFF_D)),
        "diff_lambda": 0.1 * jax.random.normal(ks[13], (DEPTH, 4, DIFF_D), f32),
        "diff_subln_g": gain(ks[14], (DEPTH, DIFF_V)),
        "mem_norm_g": gain(ks[15], (DEPTH, D_MODEL)),
        "w_mem_kv": nrm(ks[16], (DEPTH, D_MODEL, 2 * MEM_W), D_MODEL),
        "mem_qn_g": gain(ks[17], (DEPTH, MEM_D)),
        "mem_kn_g": gain(ks[18], (DEPTH, MEM_D)),
        "w_out": nrm(ks[19], (DEPTH, D_MIX, D_MODEL), D_MIX),
    }


def reference(x, mem, positions, norm_g, w_in, mla_q_norm_g, mla_kv_norm_g, w_uq, w_ukv,
              mla_qn_g, mla_kn_g, diff_qn_g, diff_kn_g, diff_lambda, diff_subln_g,
              mem_norm_g, w_mem_kv, mem_qn_g, mem_kn_g, w_out):
    for l in range(DEPTH):
        lam_init = 0.8 - 0.6 * math.exp(-0.3 * l)
        h = rms_norm(x, norm_g[l])
        proj = h @ w_in[l]
        cq, ckv, kr, dq, dk, dv, mq, z = jnp.split(proj, IN_OFFSETS, axis=-1)
        y_mla = mla_branch(cq, ckv, kr, positions, mla_q_norm_g[l], mla_kv_norm_g[l],
                           w_uq[l], w_ukv[l], mla_qn_g[l], mla_kn_g[l])
        y_diff = diff_branch(dq, dk, dv, positions, diff_qn_g[l], diff_kn_g[l],
                             diff_lambda[l], diff_subln_g[l], lam_init)
        y_mem = mem_branch(mq, mem, mem_norm_g[l], w_mem_kv[l], mem_qn_g[l], mem_kn_g[l])
        y = jnp.concatenate([y_mla, y_diff, y_mem], axis=-1) * jax.nn.silu(z)
        x = x + y @ w_out[l]
    return x
```

```cpp
#include <hip/hip_runtime.h>
#include <hip/hip_bf16.h>
#include <cstdio>
#include <cstdint>
#include <cmath>

constexpr int D_MODEL = 1024, BATCH = 2, SEQ = 8192, DEPTH = 2, MEM_TOKENS = 256;
constexpr int NTOK = BATCH * SEQ;
constexpr float RMS_EPS = 1e-6f;
constexpr int MLA_HEADS = 8, Q_LORA = 256, KV_LORA = 128, MLA_NOPE = 64, MLA_ROPE = 32, MLA_QK = 96, MLA_V = 64;
constexpr int DIFF_HEADS = 4, DIFF_D = 32, DIFF_V = 64;
constexpr int MEM_HEADS = 4, MEM_D = 64;
constexpr int D_MIX = 1024, D_IN = 2464;
constexpr int OFF_CQ = 0, OFF_CKV = 256, OFF_KR = 384, OFF_DQ = 416, OFF_DK = 672, OFF_DV = 928, OFF_MQ = 1184, OFF_Z = 1440;


namespace pg8 {
#define PG8_LAS __attribute__((address_space(3)))
typedef unsigned short bf16_t;
typedef short bf16x8 __attribute__((ext_vector_type(8)));
typedef float f32x4 __attribute__((ext_vector_type(4)));
typedef unsigned u32x4 __attribute__((ext_vector_type(4)));
constexpr int BM = 256, BK = 64, HALF = 128, HTB = HALF * BK * 2  , STAGE_BYTES = 8 * HTB, NXCD = 8, WGM = 8;

__host__ __device__ __forceinline__ int lds_byte(int r, int c) { const int st = (r >> 4) * 2 + (c >> 5), rr = r & 15, cc = c & 31, ob = rr * 64 + cc * 2; return st * 1024 + (ob ^ (((ob >> 9) & 1) << 5)); }
__host__ __device__ __forceinline__ void stage_rc(int b, int& R, int& C) { const int st = b / 1024, sb = b % 1024, swz = sb ^ (((sb >> 9) & 1) << 5); R = (st >> 1) * 16 + swz / 64; C = (st & 1) * 32 + (swz % 64) / 2; }
__host__ __device__ __forceinline__ int perm32(int rho) { const int n = rho >> 4, i = rho & 15; return 8 * (i >> 2) + 4 * n + (i & 3); }

struct Unit { int pm, pn; };
struct Gemm { const bf16_t* A; const bf16_t* Bt; int M, N, K; };

struct StaticOrder {
    int nM, nN, nwg, G, c;
    __host__ __device__ void init(int M, int N, int G_, int c_) { nM = M / BM; nN = N / BM; nwg = nM * nN; G = G_; c = c_; }
    __host__ __device__ bool next(int i, Unit& u) const {
        const long L = (long)i * G + c; if (L >= nwg) return false;
        int wgid = (int)L; { const int q = nwg / NXCD, r = nwg % NXCD, xcd = wgid % NXCD, off = wgid / NXCD; wgid = (xcd < r ? xcd * (q + 1) : r * (q + 1) + (xcd - r) * q) + off; }
        const int nig = WGM * nN, gid = wgid / nig, fm = gid * WGM, gsz = (nM - fm) < WGM ? (nM - fm) : WGM;
        u.pm = fm + ((wgid % nig) % gsz); u.pn = (wgid % nig) / gsz; return true;
    }
    __device__ __forceinline__ void a_ready(const Unit&) const {}
    __device__ __forceinline__ void done(const Unit&) const {}
};


template <class Epi, class Sched, bool ALIGN_EPI = false, bool SP2 = false>
__device__ __forceinline__ void gemm_phase(PG8_LAS unsigned char* lds, const Gemm g, const Sched& S, const Epi& E) {
    const int tid = threadIdx.x, wid = __builtin_amdgcn_readfirstlane(tid >> 6), lane = tid & 63, wr = wid >> 2, wc = wid & 3, fr = lane & 15, fq = lane >> 4;
    const int K = g.K, nt = K / BK;
    unsigned voffA[2], voffB[2];
#pragma unroll
    for (int i = 0; i < 2; ++i) { int R, C; stage_rc(tid * 16 + i * 8192, R, C); const int Rb = Epi::PERM ? ((R & ~31) + perm32(R & 31)) : R;
        voffA[i] = (unsigned)(R * K + C) * 2u; voffB[i] = (unsigned)(Rb * K + C) * 2u; }
    const size_t kstep = (size_t)(BK * 2);
    const size_t hstep = (size_t)HALF * K * 2;
    const size_t tstep = 2 * hstep;
    const unsigned ldsw = (unsigned)wid * 1024u;
    const int aoff = lds_byte(wr * 64 + fr, fq * 8), boff = lds_byte(wc * 32 + fr, fq * 8);
#define PG8_SA(b, h) (((b) * 2 + (h)) * HTB)
#define PG8_SB(b, h) ((4 + (b) * 2 + (h)) * HTB)
#define PG8_STAGE(bufoff, gbase, voff) do { _Pragma("unroll") for (int _i = 0; _i < 2; ++_i) \
        __builtin_amdgcn_global_load_lds((const unsigned*)((const char*)(gbase) + (voff)[_i]), (PG8_LAS unsigned*)(lds + (bufoff) + ldsw + _i * 8192), 16, 0, 0); } while (0)
#define PG8_LDA(dst, b, h) do { _Pragma("unroll") for (int m = 0; m < 4; ++m) _Pragma("unroll") for (int k = 0; k < 2; ++k) dst[m][k] = *(const PG8_LAS bf16x8*)(lds + PG8_SA(b, h) + aoff + m * 2048 + k * 1024); } while (0)
#define PG8_LDB(dst, b, h) do { _Pragma("unroll") for (int n = 0; n < 2; ++n) _Pragma("unroll") for (int k = 0; k < 2; ++k) dst[n][k] = *(const PG8_LAS bf16x8*)(lds + PG8_SB(b, h) + boff + n * 2048 + k * 1024); } while (0)
#define PG8_MMA(ai, bj, At, Bt) do { __builtin_amdgcn_s_setprio(1); _Pragma("unroll") for (int m = 0; m < 4; ++m) _Pragma("unroll") for (int n = 0; n < 2; ++n) _Pragma("unroll") for (int k = 0; k < 2; ++k) \
        acc[ai][bj][m][n] = __builtin_amdgcn_mfma_f32_16x16x32_bf16(Bt[n][k], At[m][k], acc[ai][bj][m][n], 0, 0, 0); __builtin_amdgcn_s_setprio(0); } while (0)
#define PG8_WAIT_V(n) asm volatile("s_waitcnt vmcnt(" #n ")" ::: "memory")
#define PG8_WAIT_L(n) asm volatile("s_waitcnt lgkmcnt(" #n ")" ::: "memory")
#define PG8_BAR __builtin_amdgcn_s_barrier()
#define PG8_SCHED __builtin_amdgcn_sched_barrier(0)
    Unit cur, nxt; int ui = 0;
    if (!S.next(0, cur)) return;
    f32x4 acc[2][2][4][2];
#pragma unroll
    for (int a = 0; a < 2; ++a)
#pragma unroll
        for (int b = 0; b < 2; ++b)
#pragma unroll
            for (int m = 0; m < 4; ++m)
#pragma unroll
                for (int n = 0; n < 2; ++n) acc[a][b][m][n] = (f32x4){0.f, 0.f, 0.f, 0.f};
    bf16x8 At[4][2], B0[2][2], B1[2][2];
    const char* cA = (const char*)g.A + (size_t)cur.pm * tstep; const char* cB = (const char*)g.Bt + (size_t)cur.pn * tstep;
    S.a_ready(cur);
    if constexpr (SP2) {
        PG8_STAGE(PG8_SB(0, 0), cB, voffB); PG8_STAGE(PG8_SB(0, 1), cB + hstep, voffB); PG8_STAGE(PG8_SA(0, 0), cA, voffA); PG8_STAGE(PG8_SA(0, 1), cA + hstep, voffA);
        if (wr == 1) PG8_BAR;
        PG8_WAIT_V(2); PG8_BAR;
        PG8_STAGE(PG8_SB(1, 0), cB + kstep, voffB); PG8_STAGE(PG8_SA(1, 0), cA + kstep, voffA); PG8_STAGE(PG8_SB(1, 1), cB + hstep + kstep, voffB);
        PG8_WAIT_V(6); PG8_BAR;
    } else {
        PG8_STAGE(PG8_SB(0, 0), cB, voffB); PG8_STAGE(PG8_SA(0, 0), cA, voffA); PG8_STAGE(PG8_SB(0, 1), cB + hstep, voffB); PG8_STAGE(PG8_SA(0, 1), cA + hstep, voffA);
        if (wr == 1) PG8_BAR;
        PG8_WAIT_V(4); PG8_BAR;
        PG8_STAGE(PG8_SB(1, 0), cB + kstep, voffB); PG8_STAGE(PG8_SA(1, 0), cA + kstep, voffA); PG8_STAGE(PG8_SB(1, 1), cB + hstep + kstep, voffB);
        PG8_WAIT_V(6); PG8_BAR;
    }
    for (;;) {
        const bool has_next = S.next(ui + 1, nxt);
        const char* nA = has_next ? (const char*)g.A + (size_t)nxt.pm * tstep : cA; const char* nB = has_next ? (const char*)g.Bt + (size_t)nxt.pn * tstep : cB;
        for (int t = 0; t < nt; t += 2) {
            const bool last = (t == nt - 2);
            const char* a1 = cA + (size_t)(t + 1) * kstep;
            const char* a2 = last ? nA : cA + (size_t)(t + 2) * kstep; const char* b2 = last ? nB : cB + (size_t)(t + 2) * kstep;
            const char* a3 = a2 + kstep; const char* b3 = b2 + kstep;
            if (last && has_next) S.a_ready(nxt);
            if constexpr (SP2) {
            PG8_LDB(B0, 0, 0); PG8_LDB(B1, 0, 1); PG8_SCHED; PG8_LDA(At, 0, 0); PG8_STAGE(PG8_SA(1, 1), a1 + hstep, voffA);
            PG8_WAIT_V(8); PG8_WAIT_L(0); PG8_BAR; PG8_MMA(0, 0, At, B0); PG8_MMA(0, 1, At, B1); PG8_BAR; PG8_SCHED;
            PG8_LDA(At, 0, 1); PG8_STAGE(PG8_SB(0, 0), b2, voffB); PG8_STAGE(PG8_SB(0, 1), b2 + hstep, voffB); PG8_STAGE(PG8_SA(0, 0), a2, voffA);
            PG8_WAIT_V(8); PG8_WAIT_L(0); PG8_BAR; PG8_MMA(1, 0, At, B0); PG8_MMA(1, 1, At, B1); PG8_BAR; PG8_SCHED;
            PG8_LDB(B0, 1, 0); PG8_LDB(B1, 1, 1); PG8_SCHED; PG8_LDA(At, 1, 0); PG8_STAGE(PG8_SA(0, 1), a2 + hstep, voffA);
            PG8_WAIT_V(8); PG8_WAIT_L(0); PG8_BAR; PG8_MMA(0, 0, At, B0); PG8_MMA(0, 1, At, B1); PG8_BAR; PG8_SCHED;
            PG8_LDA(At, 1, 1); PG8_STAGE(PG8_SB(1, 0), b3, voffB); PG8_STAGE(PG8_SB(1, 1), b3 + hstep, voffB); PG8_STAGE(PG8_SA(1, 0), a3, voffA);
            PG8_WAIT_V(8); PG8_WAIT_L(0); PG8_BAR; PG8_MMA(1, 0, At, B0); PG8_MMA(1, 1, At, B1); PG8_BAR; PG8_SCHED;
            } else {
            PG8_LDB(B0, 0, 0); PG8_SCHED; PG8_LDA(At, 0, 0); PG8_STAGE(PG8_SA(1, 1), a1 + hstep, voffA);
            PG8_WAIT_L(8); PG8_BAR; PG8_WAIT_L(0); PG8_MMA(0, 0, At, B0); PG8_BAR; PG8_SCHED;
            PG8_LDB(B1, 0, 1); PG8_STAGE(PG8_SB(0, 0), b2, voffB);
            PG8_BAR; PG8_WAIT_L(0); PG8_MMA(0, 1, At, B1); PG8_BAR;
            PG8_LDA(At, 0, 1); PG8_STAGE(PG8_SA(0, 0), a2, voffA);
            PG8_BAR; PG8_WAIT_L(0); PG8_MMA(1, 0, At, B0); PG8_BAR; PG8_SCHED;
            PG8_STAGE(PG8_SB(0, 1), b2 + hstep, voffB);
            PG8_WAIT_V(6); PG8_BAR; PG8_MMA(1, 1, At, B1); PG8_BAR;
            PG8_LDB(B0, 1, 0); PG8_SCHED; PG8_LDA(At, 1, 0); PG8_STAGE(PG8_SA(0, 1), a2 + hstep, voffA);
            PG8_WAIT_L(8); PG8_BAR; PG8_WAIT_L(0); PG8_MMA(0, 0, At, B0); PG8_BAR; PG8_SCHED;
            PG8_LDB(B1, 1, 1); PG8_STAGE(PG8_SB(1, 0), b3, voffB);
            PG8_BAR; PG8_WAIT_L(0); PG8_MMA(0, 1, At, B1); PG8_BAR;
            PG8_LDA(At, 1, 1); PG8_STAGE(PG8_SA(1, 0), a3, voffA);
            PG8_BAR; PG8_WAIT_L(0); PG8_MMA(1, 0, At, B0); PG8_BAR; PG8_SCHED;
            PG8_STAGE(PG8_SB(1, 1), b3 + hstep, voffB);
            PG8_WAIT_V(6); PG8_BAR; PG8_MMA(1, 1, At, B1); PG8_BAR;
            }
        }
        if constexpr (ALIGN_EPI) { if (wr == 0) PG8_BAR; }
        if constexpr (!Epi::AFTER_DRAIN) { E(acc, cur, wr, wc, fr, fq); S.done(cur); }
        if (!has_next) break;
#pragma unroll
        for (int a = 0; a < 2; ++a)
#pragma unroll
            for (int b = 0; b < 2; ++b)
#pragma unroll
                for (int m = 0; m < 4; ++m)
#pragma unroll
                    for (int n = 0; n < 2; ++n) acc[a][b][m][n] = (f32x4){0.f, 0.f, 0.f, 0.f};
        cur = nxt; cA = nA; cB = nB; ++ui;
        if constexpr (ALIGN_EPI) { if (wr == 1) PG8_BAR; }
    }
    PG8_WAIT_V(0);
    if constexpr (!ALIGN_EPI) { if (wr == 0) PG8_BAR; }
    PG8_BAR;
    if constexpr (Epi::AFTER_DRAIN) { E.fused(acc, cur, wr, wc, fr, fq, lds, wid, lane); S.done(cur); }
#undef PG8_SA
#undef PG8_SB
#undef PG8_STAGE
#undef PG8_LDA
#undef PG8_LDB
#undef PG8_MMA
#undef PG8_WAIT_V
#undef PG8_WAIT_L
#undef PG8_BAR
#undef PG8_SCHED
}
}

namespace fx {
#define LAS __attribute__((address_space(3)))
typedef unsigned short bf16_t;
typedef short bf16x8 __attribute__((ext_vector_type(8)));
typedef float f32x4 __attribute__((ext_vector_type(4)));
typedef float f32x2 __attribute__((ext_vector_type(2)));
typedef float f32x16 __attribute__((ext_vector_type(16)));
typedef unsigned u32x4 __attribute__((ext_vector_type(4)));
typedef unsigned u32x2 __attribute__((ext_vector_type(2)));
typedef __bf16 bf16x2_t __attribute__((ext_vector_type(2)));
typedef LAS unsigned char lds_u8;

constexpr int NWAVES = 8, NTHREADS = 512;
constexpr int PROJ_PITCH = 2560;
constexpr float LOG2E = 1.4426950408889634f;
constexpr size_t MiB = (size_t)1 << 20;
constexpr size_t WS_CTL = 0, CTL_ZERO_BYTES = 256 * 1024;
constexpr size_t WS_WTIN = 1 * MiB;
constexpr size_t WS_WTUQ = 13 * MiB;
constexpr size_t WS_WTUKV = 14 * MiB;
constexpr size_t WS_WTOUT = 15 * MiB;
constexpr size_t WS_ROPE = 19 * MiB;
constexpr size_t WS_XN = 21 * MiB;
constexpr size_t WS_PROJ = 54 * MiB;
constexpr size_t WS_MEMKV = 134 * MiB;
constexpr size_t WS_QMLA = 135 * MiB, WS_KMLA = 159 * MiB, WS_VMLA = 183 * MiB;
constexpr size_t WS_QDIF = 199 * MiB, WS_KDIF = 207 * MiB, WS_VDIF = 215 * MiB;
constexpr size_t WS_QMEM = 223 * MiB, WS_KMEM = 231 * MiB, WS_VMEM = 231 * MiB + 512 * 1024;
constexpr size_t WS_END = 232 * MiB;
constexpr int CTL_SC = 4096, CTL_Q = 8192, CTL_BAR = 16384;
enum { SC_LAM = 0, SC_OSCALE = 1, SC_NEGM_MLA = 2, SC_NEGM_DIF = 3, SC_NEGM_MEM = 4 };

struct Params {
    const float *x, *mem; const int* pos;
    const float *norm_g, *w_in, *q_norm_g, *kv_norm_g, *w_uq, *w_ukv, *qn_g, *kn_g, *dqn_g, *dkn_g, *dlam, *subln_g, *mem_norm_g, *w_mem_kv, *mqn_g, *mkn_g, *w_out;
    float* out; unsigned char* ws;
    int ph_lo, ph_hi;
};

__device__ __forceinline__ float bflo(unsigned w) { return __uint_as_float(w << 16); }
__device__ __forceinline__ float bfhi(unsigned w) { return __uint_as_float(w & 0xffff0000u); }
__device__ __forceinline__ unsigned pk2(float lo, float hi) { f32x2 v = {lo, hi}; bf16x2_t b = __builtin_convertvector(v, bf16x2_t); return __builtin_bit_cast(unsigned, b); }
__device__ __forceinline__ int crow(int r, int hi) { return (r & 3) + 8 * (r >> 2) + 4 * hi; }
__device__ __forceinline__ float xsum32(float v) { return v + __shfl_xor(v, 32); }
#define MFMA32(a, b, c) __builtin_amdgcn_mfma_f32_32x32x16_bf16((a), (b), (c), 0, 0, 0)

__device__ __forceinline__ void load_tile16(const bf16_t* p, int hi, f32x16& v) {
#pragma unroll
    for (int g = 0; g < 4; ++g) { const u32x2 w = *(const u32x2*)(p + 8 * g + 4 * hi); v[4 * g] = bflo(w.x); v[4 * g + 1] = bfhi(w.x); v[4 * g + 2] = bflo(w.y); v[4 * g + 3] = bfhi(w.y); }
}
__device__ __forceinline__ void load_gain16(const float* p, int hi, f32x16& v) {
#pragma unroll
    for (int g = 0; g < 4; ++g) { const f32x4 w = *(const f32x4*)(p + 8 * g + 4 * hi); v[4 * g] = w.x; v[4 * g + 1] = w.y; v[4 * g + 2] = w.z; v[4 * g + 3] = w.w; }
}
__device__ __forceinline__ float sumsq16(const f32x16& v) { float s = 0.f;
#pragma unroll
    for (int r = 0; r < 16; ++r) s += v[r] * v[r];
    return s; }
__device__ __forceinline__ u32x4 pack8(const f32x16& v, int s) { u32x4 o; o.x = pk2(v[8 * s], v[8 * s + 1]); o.y = pk2(v[8 * s + 2], v[8 * s + 3]); o.z = pk2(v[8 * s + 4], v[8 * s + 5]); o.w = pk2(v[8 * s + 6], v[8 * s + 7]); return o; }
__device__ __forceinline__ void rope16(f32x16& v, const f32x2* cs, int hi) {
#pragma unroll
    for (int g = 0; g < 2; ++g) {
        const f32x4 a = *(const f32x4*)(cs + 8 * g + 4 * hi), b = *(const f32x4*)(cs + 8 * g + 4 * hi + 2);
        const float c[4] = {a.x, a.z, b.x, b.z}, s[4] = {a.y, a.w, b.y, b.w};
#pragma unroll
        for (int e = 0; e < 4; ++e) { const int r = 4 * g + e; const float x1 = v[r], x2 = v[r + 8]; v[r] = x1 * c[e] - x2 * s[e]; v[r + 8] = x2 * c[e] + x1 * s[e]; }
    }
}

__device__ __forceinline__ void p0_transpose_item(const float* W, int K, int N, bf16_t* WT, int row_off, const float* gain, LAS float* scr, int item, int lane) {
    const int nblk = N / 32, kb = item / nblk, nb = item % nblk, k0 = 64 * kb, n0 = 32 * nb;
#pragma unroll 8
    for (int i = 0; i < 32; ++i) { const int kk = 2 * i + (lane >> 5); float w = W[(size_t)(k0 + kk) * N + n0 + (lane & 31)]; if (gain) w *= gain[k0 + kk]; scr[kk * 33 + (lane & 31)] = w; }
    asm volatile("s_waitcnt lgkmcnt(0)" ::: "memory");
    const int c = lane & 7;
#pragma unroll
    for (int j = 0; j < 4; ++j) { const int n = (lane >> 3) + 8 * j; const LAS float* s = scr + (8 * c) * 33 + n;
        u32x4 o; o.x = pk2(s[0 * 33], s[1 * 33]); o.y = pk2(s[2 * 33], s[3 * 33]); o.z = pk2(s[4 * 33], s[5 * 33]); o.w = pk2(s[6 * 33], s[7 * 33]);
        *(u32x4*)(WT + (size_t)(row_off + n0 + n) * K + k0 + 8 * c) = o; }
    asm volatile("s_waitcnt lgkmcnt(0)" ::: "memory");
}
__device__ __forceinline__ float wave_sum(float v) {
#pragma unroll
    for (int o = 1; o < 64; o <<= 1) v += __shfl_xor(v, o);
    return v;
}
__device__ __forceinline__ void rms_row_to_bf16(const float* xrow, bf16_t* orow, int lane) {
    const f32x4* xr = (const f32x4*)xrow + lane;
    f32x4 v[4]; float s = 0.f;
#pragma unroll
    for (int j = 0; j < 4; ++j) { v[j] = xr[64 * j]; s += (v[j].x * v[j].x + v[j].y * v[j].y) + (v[j].z * v[j].z + v[j].w * v[j].w); }
    const float rstd = 1.0f / sqrtf(wave_sum(s) * (1.f / 1024.f) + RMS_EPS);
    u32x2* o8 = (u32x2*)orow + lane;
#pragma unroll
    for (int j = 0; j < 4; ++j) { u32x2 w; w.x = pk2(v[j].x * rstd, v[j].y * rstd); w.y = pk2(v[j].z * rstd, v[j].w * rstd); o8[64 * j] = w; }
}
__device__ __forceinline__ void xn_rows(const float* x, bf16_t* XN, int nrows, int gw, int NGW, int lane) {
    for (int m = gw; m < nrows; m += NGW) rms_row_to_bf16(x + (size_t)m * 1024, XN + (size_t)m * 1024, lane);
}
__device__ __forceinline__ float absmax_n(const float* g, int n) { float m = 0.f; for (int i = 0; i < n; ++i) m = fmaxf(m, fabsf(g[i])); return m; }

__device__ __forceinline__ void p0_prologue(const Params& P, lds_u8* lds) {
    const int tid = threadIdx.x, lane = tid & 63, wave = tid >> 6;
    const int gw = blockIdx.x * NWAVES + wave, NGW = gridDim.x * NWAVES;
    unsigned char* ws = P.ws;
    LAS float* scr = (LAS float*)(lds + wave * 16384);
    bf16_t* WTIN = (bf16_t*)(ws + WS_WTIN); bf16_t* WTUQ = (bf16_t*)(ws + WS_WTUQ); bf16_t* WTUKV = (bf16_t*)(ws + WS_WTUKV); bf16_t* WTOUT = (bf16_t*)(ws + WS_WTOUT);
    constexpr int I_IN = 16 * 77, I_MEM = 16 * 16, I_UQ = 4 * 24, I_UKV = 2 * 32, I_OUT = 16 * 32, I_PAD = 96;
    constexpr int PER_L = I_IN + I_MEM + I_UQ + I_UKV + I_OUT + I_PAD;
    for (int it = gw; it < 2 * PER_L; it += NGW) {
        const int l = it / PER_L; int r = it % PER_L;
        if (r < I_IN) { p0_transpose_item(P.w_in + (size_t)l * 1024 * D_IN, 1024, D_IN, WTIN, l * 2560, P.norm_g + l * 1024, scr, r, lane); continue; } r -= I_IN;
        if (r < I_MEM) { p0_transpose_item(P.w_mem_kv + (size_t)l * 1024 * 512, 1024, 512, WTIN, 5120 + l * 512, P.mem_norm_g + l * 1024, scr, r, lane); continue; } r -= I_MEM;
        if (r < I_UQ) { p0_transpose_item(P.w_uq + (size_t)l * 256 * 768, 256, 768, WTUQ, l * 768, P.q_norm_g + l * 256, scr, r, lane); continue; } r -= I_UQ;
        if (r < I_UKV) { p0_transpose_item(P.w_ukv + (size_t)l * 128 * 1024, 128, 1024, WTUKV, l * 1024, P.kv_norm_g + l * 128, scr, r, lane); continue; } r -= I_UKV;
        if (r < I_OUT) { p0_transpose_item(P.w_out + (size_t)l * 1024 * 1024, 1024, 1024, WTOUT, l * 1024, nullptr, scr, r, lane); continue; } r -= I_OUT;
        { u32x4* row = (u32x4*)(WTIN + (size_t)(l * 2560 + D_IN + r) * 1024); const u32x4 z = {0u, 0u, 0u, 0u}; row[lane] = z; row[lane + 64] = z; }
    }
    bf16_t* XN = (bf16_t*)(ws + WS_XN);
    xn_rows(P.x, XN, NTOK, gw, NGW, lane);
    xn_rows(P.mem, XN + (size_t)NTOK * 1024, BATCH * MEM_TOKENS, gw, NGW, lane);
    f32x2* rope = (f32x2*)(ws + WS_ROPE);
    for (int e = blockIdx.x * NTHREADS + tid; e < NTOK * 16; e += gridDim.x * NTHREADS) {
        const int t = e >> 4, i = e & 15;
        const float inv = (float)pow(10000.0, -(double)(2 * i) / 32.0);
        const float ang = (float)P.pos[t] * inv;
        double r = (double)ang * 0.15915494309189535; r -= rint(r);
        const double a = r * 6.283185307179586;
        f32x2 cs; cs.x = (float)cos(a); cs.y = (float)sin(a); rope[e] = cs;
    }
    if (blockIdx.x == 0 && tid == 0) {
        float* SC = (float*)(ws + WS_CTL + CTL_SC);
        for (int l = 0; l < DEPTH; ++l) {
            const float lam_init = 0.8f - 0.6f * expf(-0.3f * (float)l);
            const float* lv = P.dlam + l * 128; float d0 = 0.f, d1 = 0.f;
            for (int i = 0; i < 32; ++i) { d0 += lv[i] * lv[32 + i]; d1 += lv[64 + i] * lv[96 + i]; }
            SC[l * 16 + SC_LAM] = expf(d0) - expf(d1) + lam_init;
            SC[l * 16 + SC_OSCALE] = 1.0f - lam_init;
            SC[l * 16 + SC_NEGM_MLA] = -1.01f * sqrtf(96.f) * LOG2E * absmax_n(P.qn_g + l * 96, 96) * absmax_n(P.kn_g + l * 96, 96);
            SC[l * 16 + SC_NEGM_DIF] = -1.01f * sqrtf(32.f) * LOG2E * absmax_n(P.dqn_g + l * 32, 32) * absmax_n(P.dkn_g + l * 32, 32);
            SC[l * 16 + SC_NEGM_MEM] = -1.01f * sqrtf(64.f) * LOG2E * absmax_n(P.mqn_g + l * 64, 64) * absmax_n(P.mkn_g + l * 64, 64);
        }
    }
}

__device__ __forceinline__ void store_q_tile(unsigned char* qimg, int nch, int qg, int ft, const f32x16& v, int r32, int hi) {
#pragma unroll
    for (int s = 0; s < 2; ++s) *(u32x4*)(qimg + ((size_t)qg * nch + 2 * (2 * ft + s) + hi) * 512 + r32 * 16) = pack8(v, s);
}
__device__ __forceinline__ void store_k_tile(unsigned char* kimg, int nch, int tile, int row64, int ft, const f32x16& v, int hi) {
#pragma unroll
    for (int s = 0; s < 2; ++s) *(u32x4*)(kimg + ((size_t)tile * nch + 2 * (2 * ft + s) + hi) * 1024 + row64 * 16) = pack8(v, s);
}
__device__ __forceinline__ void store_v_tile(unsigned char* vimg, int tile, int tg, int dt, const f32x16& v, int r32, int hi) {
#pragma unroll
    for (int s = 0; s < 2; ++s) *(u32x4*)(vimg + ((size_t)tile * 8 + 2 * (2 * tg + s) + hi) * 1024 + (32 * dt + r32) * 16) = pack8(v, s);
}
__device__ __forceinline__ void transpose_v64(const bf16_t* src_row  , unsigned char* vimg, int tile, int tg, int r32, int hi) {
    bf16x8 xf[4];
#pragma unroll
    for (int ks = 0; ks < 4; ++ks) xf[ks] = *(const bf16x8*)(src_row + 16 * ks + 8 * hi);
#pragma unroll
    for (int dt = 0; dt < 2; ++dt) {
        f32x16 acc = {};
#pragma unroll
        for (int kk = 0; kk < 2; ++kk) {
            const int ks = 2 * dt + kk;
            bf16x8 id;
#pragma unroll
            for (int j = 0; j < 8; ++j) id[j] = (16 * kk + 8 * hi + j == r32) ? (short)0x3f80 : (short)0;
            acc = MFMA32(xf[ks], id, acc);
        }
        store_v_tile(vimg, tile, tg, dt, acc, r32, hi);
    }
}

__device__ __forceinline__ void p2_tokens(const Params& P, int l) {
    const int tid = threadIdx.x, lane = tid & 63, wave = __builtin_amdgcn_readfirstlane(tid >> 6), r32 = lane & 31, hi = lane >> 5;
    unsigned char* ws = P.ws;
    const bf16_t* PROJ = (const bf16_t*)(ws + WS_PROJ);
    const float* SC = (const float*)(ws + WS_CTL + CTL_SC) + l * 16; (void)SC;
    const int tg = wave & 1, hq = wave >> 1;
    for (int blk = blockIdx.x; blk < NTOK / 64; blk += gridDim.x) {
        const int b = blk >> 7, tile = blk & 127, qg = tile * 2 + tg;
        const int T = b * SEQ + tile * 64 + 32 * tg + r32;
        const int row64 = 32 * tg + r32;
        const bf16_t* prow = PROJ + (size_t)T * PROJ_PITCH;
        const f32x2* cs = (const f32x2*)(ws + WS_ROPE) + (size_t)T * 16;
        {
            bf16x8 xq[16], xkv[8];
            float ssq = 0.f, sskv = 0.f;
#pragma unroll
            for (int ks = 0; ks < 16; ++ks) { xq[ks] = *(const bf16x8*)(prow + OFF_CQ + 16 * ks + 8 * hi);
#pragma unroll
                for (int j = 0; j < 8; ++j) { const float f = __uint_as_float((unsigned)(unsigned short)xq[ks][j] << 16); ssq += f * f; } }
#pragma unroll
            for (int ks = 0; ks < 8; ++ks) { xkv[ks] = *(const bf16x8*)(prow + OFF_CKV + 16 * ks + 8 * hi);
#pragma unroll
                for (int j = 0; j < 8; ++j) { const float f = __uint_as_float((unsigned)(unsigned short)xkv[ks][j] << 16); sskv += f * f; } }
            const float rstd_q = 1.0f / sqrtf(xsum32(ssq) * (1.f / 256.f) + RMS_EPS);
            const float rstd_kv = 1.0f / sqrtf(xsum32(sskv) * (1.f / 128.f) + RMS_EPS);
            f32x16 kr; load_tile16(prow + OFF_KR, hi, kr);
            const float sskr = sumsq16(kr);
            f32x16 rsv;
#pragma unroll
            for (int r = 0; r < 16; ++r) rsv[r] = __shfl(rstd_kv, crow(r, hi));
            const bf16_t* WQ = (const bf16_t*)(ws + WS_WTUQ) + (size_t)l * 768 * 256;
            const bf16_t* WKV = (const bf16_t*)(ws + WS_WTUKV) + (size_t)l * 1024 * 128;
            const float qscale = LOG2E / sqrtf(96.f);
#pragma unroll 1
            for (int hh = 0; hh < 2; ++hh) {
                const int h = hq + 4 * hh, bh = b * 8 + h;
                f32x16 qa[3];
#pragma unroll
                for (int ft = 0; ft < 3; ++ft) { qa[ft] = f32x16{};
                    const bf16_t* wr = WQ + (size_t)(h * 96 + 32 * ft + r32) * 256 + 8 * hi;
#pragma unroll
                    for (int ks = 0; ks < 16; ++ks) qa[ft] = MFMA32(*(const bf16x8*)(wr + 16 * ks), xq[ks], qa[ft]); }
                {
                    float ss = sumsq16(qa[0]) + sumsq16(qa[1]) + sumsq16(qa[2]);
                    ss = xsum32(ss) * rstd_q * rstd_q;
                    const float rn = rstd_q * qscale / sqrtf(ss * (1.f / 96.f) + RMS_EPS);
                    unsigned char* qimg = ws + WS_QMLA + (size_t)bh * (256 * 12 * 512);
#pragma unroll
                    for (int ft = 0; ft < 3; ++ft) { f32x16 g; load_gain16(P.qn_g + l * 96 + 32 * ft, hi, g);
#pragma unroll
                        for (int r = 0; r < 16; ++r) qa[ft][r] *= rn * g[r];
                        if (ft == 2) rope16(qa[2], cs, hi);
                        store_q_tile(qimg, 12, qg, ft, qa[ft], r32, hi); }
                }
                f32x16 ka[2];
#pragma unroll
                for (int ft = 0; ft < 2; ++ft) { ka[ft] = f32x16{};
                    const bf16_t* wr = WKV + (size_t)(h * 128 + 32 * ft + r32) * 128 + 8 * hi;
#pragma unroll
                    for (int ks = 0; ks < 8; ++ks) ka[ft] = MFMA32(*(const bf16x8*)(wr + 16 * ks), xkv[ks], ka[ft]); }
                {
                    float ss = xsum32(sumsq16(ka[0]) + sumsq16(ka[1])) * rstd_kv * rstd_kv + xsum32(sskr);
                    const float rk = 1.0f / sqrtf(ss * (1.f / 96.f) + RMS_EPS);
                    unsigned char* kimg = ws + WS_KMLA + (size_t)bh * (128 * 12 * 1024);
#pragma unroll
                    for (int ft = 0; ft < 2; ++ft) { f32x16 g; load_gain16(P.kn_g + l * 96 + 32 * ft, hi, g);
#pragma unroll
                        for (int r = 0; r < 16; ++r) ka[ft][r] *= rstd_kv * rk * g[r];
                        store_k_tile(kimg, 12, tile, row64, ft, ka[ft], hi); }
                    f32x16 g, kro; load_gain16(P.kn_g + l * 96 + 64, hi, g);
#pragma unroll
                    for (int r = 0; r < 16; ++r) kro[r] = kr[r] * rk * g[r];
                    rope16(kro, cs, hi);
                    store_k_tile(kimg, 12, tile, row64, 2, kro, hi);
                }
                {
                    unsigned char* vimg = ws + WS_VMLA + (size_t)bh * (128 * 8 * 1024);
#pragma unroll
                    for (int dt = 0; dt < 2; ++dt) { f32x16 va = {};
                        const bf16_t* wr = WKV + (size_t)(h * 128 + 64 + 32 * dt + r32) * 128 + 8 * hi;
#pragma unroll
                        for (int ks = 0; ks < 8; ++ks) va = MFMA32(xkv[ks], *(const bf16x8*)(wr + 16 * ks), va);
#pragma unroll
                        for (int r = 0; r < 16; ++r) va[r] *= rsv[r];
                        store_v_tile(vimg, tile, tg, dt, va, r32, hi); }
                }
            }
        }
        {
            const float dscale = LOG2E / sqrtf(32.f);
#pragma unroll 1
            for (int mm = 0; mm < 2; ++mm) {
                const int g = 2 * hq + mm;
                f32x16 v, gn;
                load_tile16(prow + OFF_DQ + g * 32, hi, v); load_gain16(P.dqn_g + l * 32, hi, gn);
                { const float rn = dscale / sqrtf(xsum32(sumsq16(v)) * (1.f / 32.f) + RMS_EPS);
#pragma unroll
                  for (int r = 0; r < 16; ++r) v[r] *= rn * gn[r]; }
                rope16(v, cs, hi);
                store_q_tile(ws + WS_QDIF + (size_t)(b * 8 + g) * (256 * 4 * 512), 4, qg, 0, v, r32, hi);
                load_tile16(prow + OFF_DK + g * 32, hi, v); load_gain16(P.dkn_g + l * 32, hi, gn);
                { const float rn = 1.0f / sqrtf(xsum32(sumsq16(v)) * (1.f / 32.f) + RMS_EPS);
#pragma unroll
                  for (int r = 0; r < 16; ++r) v[r] *= rn * gn[r]; }
                rope16(v, cs, hi);
                store_k_tile(ws + WS_KDIF + (size_t)(b * 8 + g) * (128 * 4 * 1024), 4, tile, row64, 0, v, hi);
            }
            transpose_v64(prow + OFF_DV + hq * 64, ws + WS_VDIF + (size_t)(b * 4 + hq) * (128 * 8 * 1024), tile, tg, r32, hi);
        }
        {
            f32x16 v0, v1, g0, g1;
            load_tile16(prow + OFF_MQ + hq * 64, hi, v0); load_tile16(prow + OFF_MQ + hq * 64 + 32, hi, v1);
            load_gain16(P.mqn_g + l * 64, hi, g0); load_gain16(P.mqn_g + l * 64 + 32, hi, g1);
            const float rn = (LOG2E * 0.125f) / sqrtf(xsum32(sumsq16(v0) + sumsq16(v1)) * (1.f / 64.f) + RMS_EPS);
#pragma unroll
            for (int r = 0; r < 16; ++r) { v0[r] *= rn * g0[r]; v1[r] *= rn * g1[r]; }
            unsigned char* qimg = ws + WS_QMEM + (size_t)(b * 4 + hq) * (256 * 8 * 512);
            store_q_tile(qimg, 8, qg, 0, v0, r32, hi); store_q_tile(qimg, 8, qg, 1, v1, r32, hi);
        }
    }
    if (l == 0) {
        for (int task = blockIdx.x * NWAVES + wave; task < 128; task += gridDim.x * NWAVES) {
            const int h = task & 3, tgm = (task >> 2) & 1, mt = (task >> 3) & 3, b = (task >> 5) & 1, lp = task >> 6;
            const bf16_t* row = (const bf16_t*)(ws + WS_MEMKV) + ((size_t)lp * 512 + b * 256 + mt * 64 + 32 * tgm + r32) * 512;
            f32x16 v0, v1, g0, g1;
            load_tile16(row + h * 64, hi, v0); load_tile16(row + h * 64 + 32, hi, v1);
            load_gain16(P.mkn_g + lp * 64, hi, g0); load_gain16(P.mkn_g + lp * 64 + 32, hi, g1);
            const float rn = 1.0f / sqrtf(xsum32(sumsq16(v0) + sumsq16(v1)) * (1.f / 64.f) + RMS_EPS);
#pragma unroll
            for (int r = 0; r < 16; ++r) { v0[r] *= rn * g0[r]; v1[r] *= rn * g1[r]; }
            unsigned char* kimg = ws + WS_KMEM + (size_t)((lp * 2 + b) * 4 + h) * (4 * 8 * 1024);
            store_k_tile(kimg, 8, mt, 32 * tgm + r32, 0, v0, hi); store_k_tile(kimg, 8, mt, 32 * tgm + r32, 1, v1, hi);
            transpose_v64(row + 256 + h * 64, ws + WS_VMEM + (size_t)((lp * 2 + b) * 4 + h) * (4 * 8 * 1024), mt, tgm, r32, hi);
        }
    }
}

constexpr int ATT_SLOT = 20480;
__device__ __forceinline__ void glds16(const void* gsrc, unsigned lds_dst) {
    unsigned keep;
    asm volatile("s_mov_b32 %0, m0\n\ts_mov_b32 m0, %2\n\ts_nop 0\n\tglobal_load_lds_dwordx4 %1, off\n\ts_mov_b32 m0, %0" : "=&s"(keep) : "v"(gsrc), "s"(lds_dst) : "memory");
}
#define ATT_WAIT_BAR() asm volatile("s_waitcnt vmcnt(0) lgkmcnt(0)\n\ts_barrier" ::: "memory")

struct AttnEpi { int kind;   int ycol; float lam, oscale; const float* subln; const bf16_t* proj; bf16_t* Y; };

template <int DQK, int NMAP>
__device__ __forceinline__ void attn_unit(lds_u8* lds, const unsigned char* qimg0, const unsigned char* qimg1, const unsigned char* kimg0, const unsigned char* kimg1,
                                          const unsigned char* vimg, int NT, bool causal, int qb, int rowbase, float negM, const AttnEpi& E) {
    constexpr int NCH = DQK / 8, NKP = NMAP * NCH, NP = NKP + 8, NDS = DQK / 16;
    const int tid = threadIdx.x, lane = tid & 63, r32 = lane & 31, hi = lane >> 5;
    const int wid = __builtin_amdgcn_readfirstlane(tid >> 6);
    const unsigned lds0 = (unsigned)(uintptr_t)lds;
    bf16x8 qf[NMAP][NDS];
#pragma unroll
    for (int m = 0; m < NMAP; ++m)
#pragma unroll
        for (int ds = 0; ds < NDS; ++ds) qf[m][ds] = *(const bf16x8*)((m ? qimg1 : qimg0) + ((size_t)(qb * 8 + wid) * NCH + 2 * ds + hi) * 512 + r32 * 16);
    f32x16 O[NMAP][2]; float lsum[NMAP];
#pragma unroll
    for (int m = 0; m < NMAP; ++m) { O[m][0] = f32x16{}; O[m][1] = f32x16{}; lsum[m] = 0.f; }
    f32x16 negm;
#pragma unroll
    for (int r = 0; r < 16; ++r) negm[r] = negM;
    asm volatile("" : "+v"(negm));
    const int qw0 = qb * 256 + 32 * wid;
    const int qrow = qw0 + r32;
#define ATT_ISSUE(t, slot) do { _Pragma("unroll") for (int p_ = wid; p_ < NP; p_ += 8) { \
        const unsigned char* s_ = (p_ < NCH) ? kimg0 + (size_t)(t) * (NCH * 1024) + p_ * 1024 : (p_ < NKP) ? kimg1 + (size_t)(t) * (NCH * 1024) + (p_ - NCH) * 1024 : vimg + (size_t)(t) * 8192 + (p_ - NKP) * 1024; \
        glds16(s_ + lane * 16, (unsigned)__builtin_amdgcn_readfirstlane(lds0 + (slot) * ATT_SLOT + p_ * 1024)); } } while (0)
    ATT_ISSUE(0, 0);
    for (int t = 0; t < NT; ++t) {
        ATT_WAIT_BAR();
        if (t + 1 < NT) ATT_ISSUE(t + 1, (t + 1) & 1);
        const int k0 = 64 * t;
        if (causal && k0 > qw0 + 31) continue;
        const bool need_mask = causal && (k0 + 63 > qw0);
        const lds_u8* slot = lds + (t & 1) * ATT_SLOT;
#pragma unroll
        for (int m = 0; m < NMAP; ++m) {
            const lds_u8* kb = slot + m * (NCH * 1024);
            f32x16 p0, p1;
#pragma unroll
            for (int ds = 0; ds < NDS; ++ds) {
                const bf16x8 ka = *(const LAS bf16x8*)(kb + (2 * ds + hi) * 1024 + r32 * 16);
                const bf16x8 kc = *(const LAS bf16x8*)(kb + (2 * ds + hi) * 1024 + (32 + r32) * 16);
                p0 = MFMA32(ka, qf[m][ds], ds == 0 ? negm : p0);
                p1 = MFMA32(kc, qf[m][ds], ds == 0 ? negm : p1);
            }
            if (need_mask) {
#pragma unroll
                for (int r = 0; r < 16; ++r) { const int key = k0 + crow(r, hi); if (key > qrow) p0[r] = -INFINITY; if (key + 32 > qrow) p1[r] = -INFINITY; }
            }
            float s = 0.f;
#pragma unroll
            for (int r = 0; r < 16; ++r) { p0[r] = __builtin_amdgcn_exp2f(p0[r]); p1[r] = __builtin_amdgcn_exp2f(p1[r]); s += p0[r] + p1[r]; }
            lsum[m] += s;
            const lds_u8* vb = slot + NKP * 1024;
#pragma unroll
            for (int j = 0; j < 2; ++j)
#pragma unroll
                for (int ss = 0; ss < 2; ++ss) {
                    const bf16x8 pf = __builtin_bit_cast(bf16x8, pack8(j ? p1 : p0, ss));
                    const int ch = 2 * (2 * j + ss) + hi;
#pragma unroll
                    for (int dt = 0; dt < 2; ++dt) {
                        const bf16x8 va = *(const LAS bf16x8*)(vb + ch * 1024 + (32 * dt + r32) * 16);
                        O[m][dt] = MFMA32(va, pf, O[m][dt]);
                    }
                }
        }
    }
#undef ATT_ISSUE
    const int T = rowbase + 32 * wid + r32;
    f32x16 o[2];
    if (NMAP == 1) {
        const float inv = 1.0f / xsum32(lsum[0]);
#pragma unroll
        for (int dt = 0; dt < 2; ++dt)
#pragma unroll
            for (int r = 0; r < 16; ++r) o[dt][r] = O[0][dt][r] * inv;
    } else {
        const float i0 = 1.0f / xsum32(lsum[0]), i1 = E.lam / xsum32(lsum[NMAP - 1]);
        float ss = 0.f;
#pragma unroll
        for (int dt = 0; dt < 2; ++dt)
#pragma unroll
            for (int r = 0; r < 16; ++r) { const float v = O[0][dt][r] * i0 - O[NMAP - 1][dt][r] * i1; o[dt][r] = v; ss += v * v; }
        const float rn = E.oscale / sqrtf(xsum32(ss) * (1.f / 64.f) + RMS_EPS);
#pragma unroll
        for (int dt = 0; dt < 2; ++dt) { f32x16 g; load_gain16(E.subln + 32 * dt, hi, g);
#pragma unroll
            for (int r = 0; r < 16; ++r) o[dt][r] *= rn * g[r]; }
    }
    const bf16_t* zrow = E.proj + (size_t)T * PROJ_PITCH + OFF_Z + E.ycol;
    bf16_t* yrow = E.Y + (size_t)T * 1024 + E.ycol;
#pragma unroll
    for (int dt = 0; dt < 2; ++dt) {
        f32x16 z; load_tile16(zrow + 32 * dt, hi, z);
#pragma unroll
        for (int g = 0; g < 4; ++g) {
            float y[4];
#pragma unroll
            for (int e = 0; e < 4; ++e) { const float zz = z[4 * g + e]; y[e] = o[dt][4 * g + e] * zz / (1.0f + __expf(-zz)); }
            u32x2 w; w.x = pk2(y[0], y[1]); w.y = pk2(y[2], y[3]);
            *(u32x2*)(yrow + 32 * dt + 8 * g + 4 * hi) = w;
        }
    }
    ATT_WAIT_BAR();
}

__device__ __forceinline__ void p3_attention(const Params& P, int l, lds_u8* lds) {
    unsigned char* ws = P.ws;
    const float* SC = (const float*)(ws + WS_CTL + CTL_SC) + l * 16;
    unsigned* qctr = (unsigned*)(ws + WS_CTL + CTL_Q + l * 256);
    LAS unsigned* sh = (LAS unsigned*)(lds + 2 * ATT_SLOT);
    AttnEpi E; E.proj = (const bf16_t*)(ws + WS_PROJ); E.Y = (bf16_t*)(ws + WS_XN); E.lam = SC[SC_LAM]; E.oscale = SC[SC_OSCALE]; E.subln = P.subln_g + l * 64;
    for (;;) {
        if (threadIdx.x == 0) sh[0] = atomicAdd(qctr, 1u);
        __syncthreads();
        const int i = (int)sh[0];
        __syncthreads();
        if (i >= 1024) break;
        if (i < 768) {
            const int qb = 31 - i / 24, j = i % 24;
            if (j < 8) {
                const int b = j >> 2, h = j & 3;
                E.kind = 1; E.ycol = 512 + h * 64;
                const unsigned char* q0 = ws + WS_QDIF + (size_t)(b * 8 + 2 * h) * (256 * 4 * 512);
                const unsigned char* k0 = ws + WS_KDIF + (size_t)(b * 8 + 2 * h) * (128 * 4 * 1024);
                attn_unit<32, 2>(lds, q0, q0 + 256 * 4 * 512, k0, k0 + 128 * 4 * 1024, ws + WS_VDIF + (size_t)(b * 4 + h) * (128 * 8 * 1024), 4 * qb + 4, true, qb, b * SEQ + qb * 256, SC[SC_NEGM_DIF], E);
            } else {
                const int bh = j - 8, b = bh >> 3, h = bh & 7;
                E.kind = 0; E.ycol = h * 64;
                const unsigned char* q0 = ws + WS_QMLA + (size_t)bh * (256 * 12 * 512);
                const unsigned char* k0 = ws + WS_KMLA + (size_t)bh * (128 * 12 * 1024);
                attn_unit<96, 1>(lds, q0, q0, k0, k0, ws + WS_VMLA + (size_t)bh * (128 * 8 * 1024), 4 * qb + 4, true, qb, b * SEQ + qb * 256, SC[SC_NEGM_MLA], E);
            }
        } else {
            const int u = i - 768, s = u >> 5, qb = u & 31, b = s >> 2, h = s & 3;
            E.kind = 2; E.ycol = 768 + h * 64;
            const unsigned char* q0 = ws + WS_QMEM + (size_t)s * (256 * 8 * 512);
            const unsigned char* k0 = ws + WS_KMEM + (size_t)((l * 2 + b) * 4 + h) * (4 * 8 * 1024);
            attn_unit<64, 1>(lds, q0, q0, k0, k0, ws + WS_VMEM + (size_t)((l * 2 + b) * 4 + h) * (4 * 8 * 1024), 4, false, qb, b * SEQ + qb * 256, SC[SC_NEGM_MEM], E);
        }
    }
}

struct SchedP1 {
    int G, c, l; bool mem;
    __device__ __forceinline__ bool next(int i, pg8::Unit& u) const {
        const long L = (long)i * G + c;
        if (L < 640) { const int w0 = (int)L, wgid = (w0 % 8) * 80 + w0 / 8; const int gid = wgid / 80, rem = wgid % 80; u.pm = gid * 8 + (rem % 8); u.pn = rem / 8 + 10 * l; return true; }
        if (mem && L < 648) { const int k = (int)L - 640; u.pm = 64 + (k & 1); u.pn = 20 + (k >> 1); return true; }
        return false;
    }
    __device__ __forceinline__ void a_ready(const pg8::Unit&) const {}
    __device__ __forceinline__ void done(const pg8::Unit&) const {}
};
struct EpiProj {
    static constexpr bool PERM = true, AFTER_DRAIN = false;
    bf16_t* proj; bf16_t* memkv; int l;
    __device__ __forceinline__ void operator()(const pg8::f32x4 (&acc)[2][2][4][2], const pg8::Unit& u, int wr, int wc, int fr, int fq) const {
        bf16_t* base; int ldc, row0, colt;
        if (u.pm < 64) { base = proj; ldc = PROJ_PITCH; row0 = u.pm * 256; colt = (u.pn - 10 * l) * 256; }
        else { const int k = u.pn - 20; base = memkv + (size_t)(k >> 1) * 512 * 512; ldc = 512; row0 = (u.pm - 64) * 256; colt = (k & 1) * 256; }
        row0 += wr * 64 + fr; const int col0 = colt + wc * 32 + 8 * fq;
#pragma unroll
        for (int ai = 0; ai < 2; ++ai)
#pragma unroll
            for (int m = 0; m < 4; ++m) { bf16_t* rowp = base + (size_t)(row0 + ai * 128 + m * 16) * ldc + col0;
#pragma unroll
                for (int bj = 0; bj < 2; ++bj) { const pg8::f32x4 v0 = acc[ai][bj][m][0], v1 = acc[ai][bj][m][1];
                    u32x4 w; w.x = pk2(v0[0], v0[1]); w.y = pk2(v0[2], v0[3]); w.z = pk2(v1[0], v1[1]); w.w = pk2(v1[2], v1[3]);
                    *(u32x4*)(rowp + bj * 128) = w; } }
    }
};
struct EpiResid {
    static constexpr bool PERM = false, AFTER_DRAIN = false;
    const float* base; float* out;
    __device__ __forceinline__ void operator()(const pg8::f32x4 (&acc)[2][2][4][2], const pg8::Unit& u, int wr, int wc, int fr, int fq) const {
        const int col0 = u.pn * 256 + wc * 32 + 4 * fq;
#pragma unroll
        for (int ai = 0; ai < 2; ++ai)
#pragma unroll
            for (int m = 0; m < 4; ++m) { const size_t off = (size_t)(u.pm * 256 + ai * 128 + wr * 64 + m * 16 + fr) * 1024 + col0;
#pragma unroll
                for (int bj = 0; bj < 2; ++bj)
#pragma unroll
                    for (int n = 0; n < 2; ++n) { const pg8::f32x4 bs = *(const pg8::f32x4*)(base + off + bj * 128 + n * 16); *(pg8::f32x4*)(out + off + bj * 128 + n * 16) = bs + acc[ai][bj][m][n]; } }
    }
};

__device__ __forceinline__ void p1_inproj(const Params& P, int l, lds_u8* lds) {
    unsigned char* ws = P.ws;
    pg8::Gemm g{(const pg8::bf16_t*)(ws + WS_XN), (const pg8::bf16_t*)(ws + WS_WTIN), 16896, 6144, 1024};
    SchedP1 S{(int)gridDim.x, (int)blockIdx.x, l, l == 0};
    EpiProj E{(bf16_t*)(ws + WS_PROJ), (bf16_t*)(ws + WS_MEMKV), l};
    pg8::gemm_phase<EpiProj, SchedP1, true, true>(lds, g, S, E);
}
__device__ __forceinline__ void p4_outproj(const Params& P, int l, lds_u8* lds) {
    unsigned char* ws = P.ws;
    pg8::Gemm g{(const pg8::bf16_t*)(ws + WS_XN), (const pg8::bf16_t*)(ws + WS_WTOUT) + (size_t)l * 1024 * 1024, NTOK, 1024, 1024};
    pg8::StaticOrder S; S.init(NTOK, 1024, (int)gridDim.x, (int)blockIdx.x);
    EpiResid E{l == 0 ? P.x : P.out, P.out};
    pg8::gemm_phase<EpiResid, pg8::StaticOrder, true, true>(lds, g, S, E);
}
__device__ __forceinline__ void p0b_xn(const Params& P) {
    const int tid = threadIdx.x, lane = tid & 63, wave = tid >> 6;
    xn_rows(P.out, (bf16_t*)(P.ws + WS_XN), NTOK, blockIdx.x * NWAVES + wave, gridDim.x * NWAVES, lane);
}

constexpr int LDS_BYTES = 147456;
template <int KIND>
__global__ void __launch_bounds__(NTHREADS, 2) fwd_phase(Params P, int l) {
    extern __shared__ __attribute__((aligned(16))) unsigned char lds_raw[];
    lds_u8* lds = (lds_u8*)lds_raw;
    if (KIND == 0) p0_prologue(P, lds);
    else if (KIND == 1) p0b_xn(P);
    else if (KIND == 2) p1_inproj(P, l, lds);
    else if (KIND == 3) p2_tokens(P, l);
    else if (KIND == 4) p3_attention(P, l, lds);
    else p4_outproj(P, l, lds);
}
}

static void fill_params(fx::Params& P, void* const* d_in, void* d_out, void* d_ws) {
    P.x = (const float*)d_in[0]; P.mem = (const float*)d_in[1]; P.pos = (const int*)d_in[2]; P.norm_g = (const float*)d_in[3]; P.w_in = (const float*)d_in[4];
    P.q_norm_g = (const float*)d_in[5]; P.kv_norm_g = (const float*)d_in[6]; P.w_uq = (const float*)d_in[7]; P.w_ukv = (const float*)d_in[8];
    P.qn_g = (const float*)d_in[9]; P.kn_g = (const float*)d_in[10]; P.dqn_g = (const float*)d_in[11]; P.dkn_g = (const float*)d_in[12];
    P.dlam = (const float*)d_in[13]; P.subln_g = (const float*)d_in[14]; P.mem_norm_g = (const float*)d_in[15]; P.w_mem_kv = (const float*)d_in[16];
    P.mqn_g = (const float*)d_in[17]; P.mkn_g = (const float*)d_in[18]; P.w_out = (const float*)d_in[19];
    P.out = (float*)d_out; P.ws = (unsigned char*)d_ws;
}

extern "C" void kernel_launch(void* const* d_in, const int* in_sizes, int n_in, void* d_out, int out_size, void* d_ws, size_t ws_size, hipStream_t stream) {
    static int ready = 0;
    if (!ready) {
        if (n_in != 20 || out_size != NTOK * D_MODEL || ws_size < fx::WS_END) { fprintf(stderr, "kernel_launch: unexpected shapes (n_in %d out %d ws %zu)\n", n_in, out_size, ws_size); ready = -1; return; }
        bool ok = true;
        ok &= hipFuncSetAttribute((const void*)fx::fwd_phase<0>, hipFuncAttributeMaxDynamicSharedMemorySize, fx::LDS_BYTES) == hipSuccess;
        ok &= hipFuncSetAttribute((const void*)fx::fwd_phase<1>, hipFuncAttributeMaxDynamicSharedMemorySize, fx::LDS_BYTES) == hipSuccess;
        ok &= hipFuncSetAttribute((const void*)fx::fwd_phase<2>, hipFuncAttributeMaxDynamicSharedMemorySize, fx::LDS_BYTES) == hipSuccess;
        ok &= hipFuncSetAttribute((const void*)fx::fwd_phase<3>, hipFuncAttributeMaxDynamicSharedMemorySize, fx::LDS_BYTES) == hipSuccess;
        ok &= hipFuncSetAttribute((const void*)fx::fwd_phase<4>, hipFuncAttributeMaxDynamicSharedMemorySize, fx::LDS_BYTES) == hipSuccess;
        ok &= hipFuncSetAttribute((const void*)fx::fwd_phase<5>, hipFuncAttributeMaxDynamicSharedMemorySize, fx::LDS_BYTES) == hipSuccess;
        if (!ok) { fprintf(stderr, "kernel_launch: hipFuncSetAttribute failed\n"); ready = -1; return; }
        ready = 1;
    }
    if (ready < 0) return;
    (void)hipMemsetAsync((char*)d_ws + fx::WS_CTL, 0, fx::CTL_ZERO_BYTES, stream);
    fx::Params P{}; fill_params(P, d_in, d_out, d_ws);
    const dim3 G(256), B(fx::NTHREADS);
    hipLaunchKernelGGL(fx::fwd_phase<0>, G, B, fx::LDS_BYTES, stream, P, 0);
    for (int l = 0; l < DEPTH; ++l) {
        if (l > 0) hipLaunchKernelGGL(fx::fwd_phase<1>, G, B, fx::LDS_BYTES, stream, P, l);
        hipLaunchKernelGGL(fx::fwd_phase<2>, G, B, fx::LDS_BYTES, stream, P, l);
        hipLaunchKernelGGL(fx::fwd_phase<3>, G, B, fx::LDS_BYTES, stream, P, l);
        hipLaunchKernelGGL(fx::fwd_phase<4>, G, B, fx::LDS_BYTES, stream, P, l);
        hipLaunchKernelGGL(fx::fwd_phase<5>, G, B, fx::LDS_BYTES, stream, P, l);
    }
}
```

```cpp
#include <hip/hip_runtime.h>
#include <hip/hip_bf16.h>
#include <hip/hip_cooperative_groups.h>
namespace cg = cooperative_groups;
#include <cstdio>
#include <cstdint>
#include <cmath>

constexpr int D_MODEL = 1024, BATCH = 2, SEQ = 8192, DEPTH = 2, MEM_TOKENS = 256;
constexpr int NTOK = BATCH * SEQ;
constexpr float RMS_EPS = 1e-6f;
constexpr int MLA_HEADS = 8, Q_LORA = 256, KV_LORA = 128, MLA_NOPE = 64, MLA_ROPE = 32, MLA_QK = 96, MLA_V = 64;
constexpr int DIFF_HEADS = 4, DIFF_D = 32, DIFF_V = 64;
constexpr int MEM_HEADS = 4, MEM_D = 64;
constexpr int D_MIX = 1024, D_IN = 2464;
constexpr int OFF_CQ = 0, OFF_CKV = 256, OFF_KR = 384, OFF_DQ = 416, OFF_DK = 672, OFF_DV = 928, OFF_MQ = 1184, OFF_Z = 1440;


namespace pg8 {
#define PG8_LAS __attribute__((address_space(3)))
typedef unsigned short bf16_t;
typedef short bf16x8 __attribute__((ext_vector_type(8)));
typedef float f32x4 __attribute__((ext_vector_type(4)));
typedef unsigned u32x4 __attribute__((ext_vector_type(4)));
constexpr int BM = 256, BK = 64, HALF = 128, HTB = HALF * BK * 2  , STAGE_BYTES = 8 * HTB, NXCD = 8, WGM = 8;

__host__ __device__ __forceinline__ int lds_byte(int r, int c) { const int st = (r >> 4) * 2 + (c >> 5), rr = r & 15, cc = c & 31, ob = rr * 64 + cc * 2; return st * 1024 + (ob ^ (((ob >> 9) & 1) << 5)); }
__host__ __device__ __forceinline__ void stage_rc(int b, int& R, int& C) { const int st = b / 1024, sb = b % 1024, swz = sb ^ (((sb >> 9) & 1) << 5); R = (st >> 1) * 16 + swz / 64; C = (st & 1) * 32 + (swz % 64) / 2; }
__host__ __device__ __forceinline__ int perm32(int rho) { const int n = rho >> 4, i = rho & 15; return 8 * (i >> 2) + 4 * n + (i & 3); }

struct Unit { int pm, pn; };
struct Gemm { const bf16_t* A; const bf16_t* Bt; int M, N, K; };

struct StaticOrder {
    int nM, nN, nwg, G, c;
    __host__ __device__ void init(int M, int N, int G_, int c_) { nM = M / BM; nN = N / BM; nwg = nM * nN; G = G_; c = c_; }
    __host__ __device__ bool next(int i, Unit& u) const {
        const long L = (long)i * G + c; if (L >= nwg) return false;
        int wgid = (int)L; { const int q = nwg / NXCD, r = nwg % NXCD, xcd = wgid % NXCD, off = wgid / NXCD; wgid = (xcd < r ? xcd * (q + 1) : r * (q + 1) + (xcd - r) * q) + off; }
        const int nig = WGM * nN, gid = wgid / nig, fm = gid * WGM, gsz = (nM - fm) < WGM ? (nM - fm) : WGM;
        u.pm = fm + ((wgid % nig) % gsz); u.pn = (wgid % nig) / gsz; return true;
    }
    __device__ __forceinline__ void a_ready(const Unit&) const {}
    __device__ __forceinline__ void done(const Unit&) const {}
};


template <class Epi, class Sched, bool ALIGN_EPI = false, bool SP2 = false>
__device__ __forceinline__ void gemm_phase(PG8_LAS unsigned char* lds, const Gemm g, const Sched& S, const Epi& E, int wv) {
    int lane_; asm volatile("v_mbcnt_lo_u32_b32 %0, -1, 0\n\tv_mbcnt_hi_u32_b32 %0, -1, %0" : "=v"(lane_)); asm volatile("" : "+s"(wv)); const int tid = (wv << 6) | lane_; const int wid = __builtin_amdgcn_readfirstlane(tid >> 6), lane = tid & 63, wr = wid >> 2, wc = wid & 3, fr = lane & 15, fq = lane >> 4;
    const int K = g.K, nt = K / BK;
    unsigned voffA[2], voffB[2];
#pragma unroll
    for (int i = 0; i < 2; ++i) { int R, C; stage_rc(tid * 16 + i * 8192, R, C); const int Rb = Epi::PERM ? ((R & ~31) + perm32(R & 31)) : R;
        voffA[i] = (unsigned)(R * K + C) * 2u; voffB[i] = (unsigned)(Rb * K + C) * 2u; }
    const size_t kstep = (size_t)(BK * 2);
    const size_t hstep = (size_t)HALF * K * 2;
    const size_t tstep = 2 * hstep;
    const unsigned ldsw = (unsigned)wid * 1024u;
    const int aoff = lds_byte(wr * 64 + fr, fq * 8), boff = lds_byte(wc * 32 + fr, fq * 8);
#define PG8_SA(b, h) (((b) * 2 + (h)) * HTB)
#define PG8_SB(b, h) ((4 + (b) * 2 + (h)) * HTB)
#define PG8_STAGE(bufoff, gbase, voff) do { _Pragma("unroll") for (int _i = 0; _i < 2; ++_i) \
        __builtin_amdgcn_global_load_lds((const unsigned*)((const char*)(gbase) + (voff)[_i]), (PG8_LAS unsigned*)(lds + (bufoff) + ldsw + _i * 8192), 16, 0, 0); } while (0)
#define PG8_LDA(dst, b, h) do { _Pragma("unroll") for (int m = 0; m < 4; ++m) _Pragma("unroll") for (int k = 0; k < 2; ++k) dst[m][k] = *(const PG8_LAS bf16x8*)(lds + PG8_SA(b, h) + aoff + m * 2048 + k * 1024); } while (0)
#define PG8_LDB(dst, b, h) do { _Pragma("unroll") for (int n = 0; n < 2; ++n) _Pragma("unroll") for (int k = 0; k < 2; ++k) dst[n][k] = *(const PG8_LAS bf16x8*)(lds + PG8_SB(b, h) + boff + n * 2048 + k * 1024); } while (0)
#define PG8_MMA(ai, bj, At, Bt) do { __builtin_amdgcn_s_setprio(1); _Pragma("unroll") for (int m = 0; m < 4; ++m) _Pragma("unroll") for (int n = 0; n < 2; ++n) _Pragma("unroll") for (int k = 0; k < 2; ++k) \
        acc[ai][bj][m][n] = __builtin_amdgcn_mfma_f32_16x16x32_bf16(Bt[n][k], At[m][k], acc[ai][bj][m][n], 0, 0, 0); __builtin_amdgcn_s_setprio(0); } while (0)
#define PG8_WAIT_V(n) asm volatile("s_waitcnt vmcnt(" #n ")" ::: "memory")
#define PG8_WAIT_L(n) asm volatile("s_waitcnt lgkmcnt(" #n ")" ::: "memory")
#define PG8_BAR __builtin_amdgcn_s_barrier()
#define PG8_SCHED __builtin_amdgcn_sched_barrier(0)
    Unit cur, nxt; int ui = 0;
    if (!S.next(0, cur)) return;
    f32x4 acc[2][2][4][2];
#pragma unroll
    for (int a = 0; a < 2; ++a)
#pragma unroll
        for (int b = 0; b < 2; ++b)
#pragma unroll
            for (int m = 0; m < 4; ++m)
#pragma unroll
                for (int n = 0; n < 2; ++n) acc[a][b][m][n] = (f32x4){0.f, 0.f, 0.f, 0.f};
    bf16x8 At[4][2], B0[2][2], B1[2][2];
    const char* cA = (const char*)g.A + (size_t)cur.pm * tstep; const char* cB = (const char*)g.Bt + (size_t)cur.pn * tstep;
    S.a_ready(cur);
    if constexpr (SP2) {
        PG8_STAGE(PG8_SB(0, 0), cB, voffB); PG8_STAGE(PG8_SB(0, 1), cB + hstep, voffB); PG8_STAGE(PG8_SA(0, 0), cA, voffA); PG8_STAGE(PG8_SA(0, 1), cA + hstep, voffA);
        if (wr == 1) PG8_BAR;
        PG8_WAIT_V(2); PG8_BAR;
        PG8_STAGE(PG8_SB(1, 0), cB + kstep, voffB); PG8_STAGE(PG8_SA(1, 0), cA + kstep, voffA); PG8_STAGE(PG8_SB(1, 1), cB + hstep + kstep, voffB);
        PG8_WAIT_V(6); PG8_BAR;
    } else {
        PG8_STAGE(PG8_SB(0, 0), cB, voffB); PG8_STAGE(PG8_SA(0, 0), cA, voffA); PG8_STAGE(PG8_SB(0, 1), cB + hstep, voffB); PG8_STAGE(PG8_SA(0, 1), cA + hstep, voffA);
        if (wr == 1) PG8_BAR;
        PG8_WAIT_V(4); PG8_BAR;
        PG8_STAGE(PG8_SB(1, 0), cB + kstep, voffB); PG8_STAGE(PG8_SA(1, 0), cA + kstep, voffA); PG8_STAGE(PG8_SB(1, 1), cB + hstep + kstep, voffB);
        PG8_WAIT_V(6); PG8_BAR;
    }
    for (;;) {
        const bool has_next = S.next(ui + 1, nxt);
        const char* nA = has_next ? (const char*)g.A + (size_t)nxt.pm * tstep : cA; const char* nB = has_next ? (const char*)g.Bt + (size_t)nxt.pn * tstep : cB;
        for (int t = 0; t < nt; t += 2) {
            const bool last = (t == nt - 2);
            const char* a1 = cA + (size_t)(t + 1) * kstep;
            const char* a2 = last ? nA : cA + (size_t)(t + 2) * kstep; const char* b2 = last ? nB : cB + (size_t)(t + 2) * kstep;
            const char* a3 = a2 + kstep; const char* b3 = b2 + kstep;
            if (last && has_next) S.a_ready(nxt);
            if constexpr (SP2) {
            PG8_LDB(B0, 0, 0); PG8_LDB(B1, 0, 1); PG8_SCHED; PG8_LDA(At, 0, 0); PG8_STAGE(PG8_SA(1, 1), a1 + hstep, voffA);
            PG8_WAIT_V(8); PG8_WAIT_L(0); PG8_BAR; PG8_MMA(0, 0, At, B0); PG8_MMA(0, 1, At, B1); PG8_BAR; PG8_SCHED;
            PG8_LDA(At, 0, 1); PG8_STAGE(PG8_SB(0, 0), b2, voffB); PG8_STAGE(PG8_SB(0, 1), b2 + hstep, voffB); PG8_STAGE(PG8_SA(0, 0), a2, voffA);
            PG8_WAIT_V(8); PG8_WAIT_L(0); PG8_BAR; PG8_MMA(1, 0, At, B0); PG8_MMA(1, 1, At, B1); PG8_BAR; PG8_SCHED;
            PG8_LDB(B0, 1, 0); PG8_LDB(B1, 1, 1); PG8_SCHED; PG8_LDA(At, 1, 0); PG8_STAGE(PG8_SA(0, 1), a2 + hstep, voffA);
            PG8_WAIT_V(8); PG8_WAIT_L(0); PG8_BAR; PG8_MMA(0, 0, At, B0); PG8_MMA(0, 1, At, B1); PG8_BAR; PG8_SCHED;
            PG8_LDA(At, 1, 1); PG8_STAGE(PG8_SB(1, 0), b3, voffB); PG8_STAGE(PG8_SB(1, 1), b3 + hstep, voffB); PG8_STAGE(PG8_SA(1, 0), a3, voffA);
            PG8_WAIT_V(8); PG8_WAIT_L(0); PG8_BAR; PG8_MMA(1, 0, At, B0); PG8_MMA(1, 1, At, B1); PG8_BAR; PG8_SCHED;
            } else {
            PG8_LDB(B0, 0, 0); PG8_SCHED; PG8_LDA(At, 0, 0); PG8_STAGE(PG8_SA(1, 1), a1 + hstep, voffA);
            PG8_WAIT_L(8); PG8_BAR; PG8_WAIT_L(0); PG8_MMA(0, 0, At, B0); PG8_BAR; PG8_SCHED;
            PG8_LDB(B1, 0, 1); PG8_STAGE(PG8_SB(0, 0), b2, voffB);
            PG8_BAR; PG8_WAIT_L(0); PG8_MMA(0, 1, At, B1); PG8_BAR;
            PG8_LDA(At, 0, 1); PG8_STAGE(PG8_SA(0, 0), a2, voffA);
            PG8_BAR; PG8_WAIT_L(0); PG8_MMA(1, 0, At, B0); PG8_BAR; PG8_SCHED;
            PG8_STAGE(PG8_SB(0, 1), b2 + hstep, voffB);
            PG8_WAIT_V(6); PG8_BAR; PG8_MMA(1, 1, At, B1); PG8_BAR;
            PG8_LDB(B0, 1, 0); PG8_SCHED; PG8_LDA(At, 1, 0); PG8_STAGE(PG8_SA(0, 1), a2 + hstep, voffA);
            PG8_WAIT_L(8); PG8_BAR; PG8_WAIT_L(0); PG8_MMA(0, 0, At, B0); PG8_BAR; PG8_SCHED;
            PG8_LDB(B1, 1, 1); PG8_STAGE(PG8_SB(1, 0), b3, voffB);
            PG8_BAR; PG8_WAIT_L(0); PG8_MMA(0, 1, At, B1); PG8_BAR;
            PG8_LDA(At, 1, 1); PG8_STAGE(PG8_SA(1, 0), a3, voffA);
            PG8_BAR; PG8_WAIT_L(0); PG8_MMA(1, 0, At, B0); PG8_BAR; PG8_SCHED;
            PG8_STAGE(PG8_SB(1, 1), b3 + hstep, voffB);
            PG8_WAIT_V(6); PG8_BAR; PG8_MMA(1, 1, At, B1); PG8_BAR;
            }
        }
        if constexpr (ALIGN_EPI) { if (wr == 0) PG8_BAR; }
        if constexpr (!Epi::AFTER_DRAIN) { E(acc, cur, wr, wc, fr, fq); S.done(cur); }
        if (!has_next) break;
#pragma unroll
        for (int a = 0; a < 2; ++a)
#pragma unroll
            for (int b = 0; b < 2; ++b)
#pragma unroll
                for (int m = 0; m < 4; ++m)
#pragma unroll
                    for (int n = 0; n < 2; ++n) acc[a][b][m][n] = (f32x4){0.f, 0.f, 0.f, 0.f};
        cur = nxt; cA = nA; cB = nB; ++ui;
        if constexpr (ALIGN_EPI) { if (wr == 1) PG8_BAR; }
    }
    PG8_WAIT_V(0);
    if constexpr (!ALIGN_EPI) { if (wr == 0) PG8_BAR; }
    PG8_BAR;
    if constexpr (Epi::AFTER_DRAIN) { E.fused(acc, cur, wr, wc, fr, fq, lds, wid, lane); S.done(cur); }
#undef PG8_SA
#undef PG8_SB
#undef PG8_STAGE
#undef PG8_LDA
#undef PG8_LDB
#undef PG8_MMA
#undef PG8_WAIT_V
#undef PG8_WAIT_L
#undef PG8_BAR
#undef PG8_SCHED
}
}

namespace xb {
#define XLAS __attribute__((address_space(3)))
__device__ __forceinline__ unsigned long long rt() { return __builtin_amdgcn_s_memrealtime(); }
#define XB_TMO      128
#define XB_XCNT(j)  (256  + 64 * (j))
#define XB_XSUB(j)  (1280 + 64 * (j))
#define XB_XGEN(j)  (2304 + 64 * (j))
#define XB_TOP      3328
#define XB_TOPGEN   3392
#define XCD_BAR_WORDS 3456
#define XB_SPIN_CAP (1u << 18)

__device__ __forceinline__ unsigned xb_ld(unsigned* p)              { return __hip_atomic_load(p, __ATOMIC_RELAXED, __HIP_MEMORY_SCOPE_AGENT); }
__device__ __forceinline__ unsigned xb_add(unsigned* p, unsigned v) { return __hip_atomic_fetch_add(p, v, __ATOMIC_RELAXED, __HIP_MEMORY_SCOPE_AGENT); }
__device__ __forceinline__ unsigned xb_xcc_id() { return (unsigned)__builtin_amdgcn_s_getreg((3 << 11) | 20) & 0xFu; }
#define XB_SPIN(cond, bar) do { unsigned _sp = 0; while (cond) { __builtin_amdgcn_s_sleep(1); \
    if ((++_sp & 255u) == 0u) { if (xb_ld(&(bar)[XB_TMO])) break; if (_sp > XB_SPIN_CAP) { atomicAdd(&(bar)[XB_TMO], 1u); break; } } } } while (0)

struct XcdBarrier {
    unsigned* bar; unsigned x;
    volatile XLAS unsigned* st;
};

__device__ __forceinline__ XcdBarrier xcd_barrier_post(unsigned* bar, volatile XLAS unsigned* st) {
    XcdBarrier b; b.bar = bar; b.x = xb_xcc_id(); b.st = st;
    if (threadIdx.x == 0) (void)xb_add(&bar[XB_XCNT(b.x)], 1u);
    return b;
}
__device__ __forceinline__ void xcd_barrier_complete(unsigned* bar, unsigned x, unsigned& nloc, unsigned& nx) {
    const unsigned G = gridDim.x * gridDim.y * gridDim.z;
    unsigned sum, cnt, mine, sp = 0u;
    for (;;) {
        sum = 0u; cnt = 0u; mine = 0u;
#pragma unroll
        for (unsigned j = 0; j < 16; ++j) { const unsigned c = xb_ld(&bar[XB_XCNT(j)]); sum += c; cnt += (c > 0u) ? 1u : 0u; mine = (j == x) ? c : mine; }
        if (sum == G) break;
        __builtin_amdgcn_s_sleep(1);
        if ((++sp & 255u) == 0u) { if (xb_ld(&bar[XB_TMO])) break; if (sp > XB_SPIN_CAP) { atomicAdd(&bar[XB_TMO], 1u); break; } }
    }
    nloc = mine > 0u ? mine : 1u; nx = cnt > 0u ? cnt : 1u;
}

__device__ __forceinline__ void xcd_barrier(const XcdBarrier& b, int wv) {
    int lane_; asm volatile("v_mbcnt_lo_u32_b32 %0, -1, 0\n\tv_mbcnt_hi_u32_b32 %0, -1, %0" : "=v"(lane_)); asm volatile("" : "+s"(wv)); const bool leader_thread = ((wv << 6) | lane_) == 0;
    asm volatile("s_waitcnt vmcnt(0)" ::: "memory");
    __syncthreads();
    if (leader_thread) {
        unsigned* bar = b.bar; asm volatile("" : "+s"(bar));
        __builtin_amdgcn_s_waitcnt(0);
        unsigned nloc = b.st[0], nx = b.st[1];
        if (nloc == 0u) { xcd_barrier_complete(bar, b.x, nloc, nx); b.st[0] = nloc; b.st[1] = nx; }
        const unsigned old = xb_add(&bar[XB_XSUB(b.x)], 1u);
        const unsigned gen = old / nloc;
        if (old + 1u == (gen + 1u) * nloc) {
            __builtin_amdgcn_fence(__ATOMIC_RELEASE, "agent");
            asm volatile("s_waitcnt vmcnt(0)" ::: "memory");
            const unsigned og = xb_add(&bar[XB_TOP], 1u);
            const unsigned tg = og / nx;
            if (og + 1u == (tg + 1u) * nx) xb_add(&bar[XB_TOPGEN], 1u);
            else XB_SPIN(xb_ld(&bar[XB_TOPGEN]) == tg, bar);
            __builtin_amdgcn_fence(__ATOMIC_ACQUIRE, "agent");
            xb_add(&bar[XB_XGEN(b.x)], 1u);
            asm volatile("s_waitcnt vmcnt(0)" ::: "memory");
        } else {
            XB_SPIN(xb_ld(&bar[XB_XGEN(b.x)]) == gen, bar);
            __builtin_amdgcn_fence(__ATOMIC_ACQUIRE, "agent");
            asm volatile("s_waitcnt vmcnt(0)" ::: "memory");
        }
    }
    __syncthreads();
}

}

#ifndef FX_PROBE
#define FX_PROBE 0
#endif
namespace fx {
#define LAS __attribute__((address_space(3)))
typedef unsigned short bf16_t;
typedef short bf16x8 __attribute__((ext_vector_type(8)));
typedef float f32x4 __attribute__((ext_vector_type(4)));
typedef float f32x2 __attribute__((ext_vector_type(2)));
typedef float f32x16 __attribute__((ext_vector_type(16)));
typedef unsigned u32x4 __attribute__((ext_vector_type(4)));
typedef unsigned u32x2 __attribute__((ext_vector_type(2)));
typedef __bf16 bf16x2_t __attribute__((ext_vector_type(2)));
typedef LAS unsigned char lds_u8;

constexpr int NWAVES = 8, NTHREADS = 512;
constexpr int PROJ_PITCH = 2560;
constexpr float LOG2E = 1.4426950408889634f;
constexpr size_t MiB = (size_t)1 << 20;
constexpr size_t WS_CTL = 0, CTL_ZERO_BYTES = 256 * 1024;
constexpr size_t WS_WTIN = 1 * MiB;
constexpr size_t WS_WTUQ = 13 * MiB;
constexpr size_t WS_WTUKV = 14 * MiB;
constexpr size_t WS_WTOUT = 15 * MiB;
constexpr size_t WS_ROPE = 19 * MiB;
constexpr size_t WS_Y = 21 * MiB;
constexpr size_t WS_PROJ = 54 * MiB;
constexpr size_t WS_MEMKV = 134 * MiB;
constexpr size_t WS_VMLA = 183 * MiB;
constexpr size_t OUT_QMLA = 0, OUT_KMLA = 24 * MiB;
constexpr size_t WS_QDIF = 199 * MiB, WS_KDIF = 207 * MiB, WS_VDIF = 215 * MiB;
constexpr size_t WS_QMEM = 223 * MiB, WS_KMEM = 231 * MiB, WS_VMEM = 231 * MiB + 512 * 1024;
constexpr size_t WS_XB = 135 * MiB;
constexpr size_t WS_ROWSS = 232 * MiB;
constexpr size_t WS_END = 234 * MiB;
constexpr int CTL_SC = 4096, CTL_Q = 8192, CTL_BAR = 16384;
enum { SC_LAM = 0, SC_OSCALE = 1 };

struct Params {
    const float *x, *mem; const int* pos;
    const float *norm_g, *w_in, *q_norm_g, *kv_norm_g, *w_uq, *w_ukv, *qn_g, *kn_g, *dqn_g, *dkn_g, *dlam, *subln_g, *mem_norm_g, *w_mem_kv, *mqn_g, *mkn_g, *w_out;
    float* out; unsigned char* ws;
    int ph_lo, ph_hi;
};

typedef const __attribute__((address_space(4))) Params& KP;
__device__ __forceinline__ const __attribute__((address_space(4))) Params* launder_kp() {
    const __attribute__((address_space(4))) Params* pk = (const __attribute__((address_space(4))) Params*)__builtin_amdgcn_kernarg_segment_ptr();
    asm volatile("" : "+s"(pk)); return pk; }
__device__ __forceinline__ int opaque_bid() { int b = blockIdx.x; asm volatile("" : "+s"(b)); return b; }
__device__ __forceinline__ int opaque_grid() { int g = gridDim.x; asm volatile("" : "+s"(g)); return g; }
__device__ __forceinline__ float bflo(unsigned w) { return __uint_as_float(w << 16); }
__device__ __forceinline__ float bfhi(unsigned w) { return __uint_as_float(w & 0xffff0000u); }
__device__ __forceinline__ unsigned pk2(float lo, float hi) { f32x2 v = {lo, hi}; bf16x2_t b = __builtin_convertvector(v, bf16x2_t); return __builtin_bit_cast(unsigned, b); }
__device__ __forceinline__ int crow(int r, int hi) { return (r & 3) + 8 * (r >> 2) + 4 * hi; }
__device__ __forceinline__ float xchg32(float v) { const auto rr = __builtin_amdgcn_permlane32_swap(__float_as_uint(v), __float_as_uint(v), false, false); return __uint_as_float(rr[0] == __float_as_uint(v) ? rr[1] : rr[0]); }
template <int XM> __device__ __forceinline__ float swz_xor(float v) { return __uint_as_float((unsigned)__builtin_amdgcn_ds_swizzle((int)__float_as_uint(v), 0x1f | (XM << 10))); }
__device__ __forceinline__ float xsum32(float v) { const auto rr = __builtin_amdgcn_permlane32_swap(__float_as_uint(v), __float_as_uint(v), false, false); return __uint_as_float(rr[0]) + __uint_as_float(rr[1]); }
__device__ __forceinline__ float xsum16_32(float v) { v += swz_xor<16>(v); return xsum32(v); }
__device__ __forceinline__ int opaque_tid(int wv) { int lane_; asm volatile("v_mbcnt_lo_u32_b32 %0, -1, 0\n\tv_mbcnt_hi_u32_b32 %0, -1, %0" : "=v"(lane_)); asm volatile("" : "+s"(wv)); return (wv << 6) | lane_; }
__device__ __forceinline__ unsigned char* opaque_ptr(unsigned char* p) { asm volatile("" : "+s"(p)); return p; }
#define GAS __attribute__((address_space(1)))
#define LDG16(p) (*(const GAS bf16x8*)(p))
#define MFMA32(a, b, c) __builtin_amdgcn_mfma_f32_32x32x16_bf16((a), (b), (c), 0, 0, 0)

__device__ __forceinline__ void load_tile16(const bf16_t* p, int hi, f32x16& v) {
#pragma unroll
    for (int g = 0; g < 4; ++g) { const u32x2 w = *(const GAS u32x2*)(p + 8 * g + 4 * hi); v[4 * g] = bflo(w.x); v[4 * g + 1] = bfhi(w.x); v[4 * g + 2] = bflo(w.y); v[4 * g + 3] = bfhi(w.y); }
}
__device__ __forceinline__ void load_gain16(const float* p, int hi, f32x16& v) {
#pragma unroll
    for (int g = 0; g < 4; ++g) { const f32x4 w = *(const GAS f32x4*)(p + 8 * g + 4 * hi); v[4 * g] = w.x; v[4 * g + 1] = w.y; v[4 * g + 2] = w.z; v[4 * g + 3] = w.w; }
}
__device__ __forceinline__ float sumsq16(const f32x16& v) { float s = 0.f;
#pragma unroll
    for (int r = 0; r < 16; ++r) s += v[r] * v[r];
    return s; }
__device__ __forceinline__ u32x4 pack8(const f32x16& v, int s) { u32x4 o; o.x = pk2(v[8 * s], v[8 * s + 1]); o.y = pk2(v[8 * s + 2], v[8 * s + 3]); o.z = pk2(v[8 * s + 4], v[8 * s + 5]); o.w = pk2(v[8 * s + 6], v[8 * s + 7]); return o; }
__device__ __forceinline__ void rope16(f32x16& v, const f32x2* cs, int hi) {
#pragma unroll
    for (int g = 0; g < 2; ++g) {
        const f32x4 a = *(const GAS f32x4*)(cs + 8 * g + 4 * hi), b = *(const GAS f32x4*)(cs + 8 * g + 4 * hi + 2);
        const float c[4] = {a.x, a.z, b.x, b.z}, s[4] = {a.y, a.w, b.y, b.w};
#pragma unroll
        for (int e = 0; e < 4; ++e) { const int r = 4 * g + e; const float x1 = v[r], x2 = v[r + 8]; v[r] = x1 * c[e] - x2 * s[e]; v[r + 8] = x2 * c[e] + x1 * s[e]; }
    }
}

__device__ __forceinline__ void glds16(const void* gsrc, unsigned lds_dst) {
    unsigned keep;
    asm volatile("s_mov_b32 %0, m0\n\ts_mov_b32 m0, %2\n\ts_nop 0\n\tglobal_load_lds_dwordx4 %1, off\n\ts_mov_b32 m0, %0" : "=&s"(keep) : "v"(gsrc), "s"(lds_dst) : "memory");
}

__device__ __forceinline__ void glds16_off(const unsigned char* sbase, unsigned voff, unsigned lds_dst) {
    unsigned keep;
    asm volatile("s_mov_b32 %0, m0\n\ts_mov_b32 m0, %3\n\ts_nop 0\n\tglobal_load_lds_dwordx4 %1, %2\n\ts_mov_b32 m0, %0" : "=&s"(keep) : "v"(voff), "s"(sbase), "s"(lds_dst) : "memory");
}
struct TItem { const float* W; const float* gain; bf16_t* WT; int K, N, row_off, img_nks, item; };
__device__ __forceinline__ void p0_item_load(const TItem& t, int lane, float (&w)[32], f32x4& g0, f32x4& g1) {
    if (t.item < 0) return;
    const int nblk = t.N / 32, kb = t.item / nblk, nb = t.item % nblk, k0 = 64 * kb, n0 = 32 * nb, c = lane & 7;
    g0 = (f32x4){1.f, 1.f, 1.f, 1.f}; g1 = g0;
    if (t.gain) { g0 = *(const GAS f32x4*)(t.gain + k0 + 8 * c); g1 = *(const GAS f32x4*)(t.gain + k0 + 8 * c + 4); }
#pragma unroll
    for (int i = 0; i < 32; ++i) w[i] = *(const GAS float*)(t.W + (size_t)(k0 + 2 * i + (lane >> 5)) * t.N + n0 + (lane & 31));
}
__device__ __forceinline__ void p0_item_finish(const TItem& t, int lane, const float (&w)[32], const f32x4& g0, const f32x4& g1, LAS float* scr) {
    if (t.item < 0) { u32x4* row = (u32x4*)(t.WT + (size_t)(t.row_off - 1 - t.item) * 1024); const u32x4 z = {0u, 0u, 0u, 0u}; row[lane] = z; row[lane + 64] = z; return; }
    const int nblk = t.N / 32, kb = t.item / nblk, nb = t.item % nblk, k0 = 64 * kb, n0 = 32 * nb, c = lane & 7;
#pragma unroll
    for (int i = 0; i < 32; ++i) scr[(2 * i + (lane >> 5)) * 33 + (lane & 31)] = w[i];
    asm volatile("s_waitcnt lgkmcnt(0)" ::: "memory");
#pragma unroll
    for (int j = 0; j < 4; ++j) { const int n = (lane >> 3) + 8 * j; const LAS float* s = scr + (8 * c) * 33 + n;
        u32x4 o; o.x = pk2(s[0 * 33] * g0[0], s[1 * 33] * g0[1]); o.y = pk2(s[2 * 33] * g0[2], s[3 * 33] * g0[3]); o.z = pk2(s[4 * 33] * g1[0], s[5 * 33] * g1[1]); o.w = pk2(s[6 * 33] * g1[2], s[7 * 33] * g1[3]);
        if (t.img_nks) *(GAS u32x4*)(t.WT + ((size_t)(((t.row_off + n0) / 32) * t.img_nks + (k0 / 16 + (c >> 1))) * 64 + (c & 1) * 32 + n) * 8) = o;
        else *(GAS u32x4*)(t.WT + (size_t)(t.row_off + n0 + n) * t.K + k0 + 8 * c) = o; }
    asm volatile("s_waitcnt lgkmcnt(0)" ::: "memory");
}
__device__ __forceinline__ float wave_sum(float v) {
    v += swz_xor<1>(v); v += swz_xor<2>(v); v += swz_xor<4>(v); v += swz_xor<8>(v); v += swz_xor<16>(v);
    return xsum32(v);
}
__device__ __forceinline__ void row_to_bf16_ss(const float* xrow, bf16_t* orow, float* ssrow, int lane) {
    const GAS f32x4* xr = (const GAS f32x4*)xrow + lane;
    f32x4 v[4]; float s = 0.f;
#pragma unroll
    for (int j = 0; j < 4; ++j) { v[j] = xr[64 * j]; s += (v[j].x * v[j].x + v[j].y * v[j].y) + (v[j].z * v[j].z + v[j].w * v[j].w); }
    s = wave_sum(s);
    GAS u32x2* o8 = (GAS u32x2*)orow + lane;
#pragma unroll
    for (int j = 0; j < 4; ++j) { u32x2 w; w.x = pk2(v[j].x, v[j].y); w.y = pk2(v[j].z, v[j].w); o8[64 * j] = w; }
    if (lane < 16) ssrow[lane] = lane == 0 ? s : 0.f;
}
__device__ __forceinline__ void xb_rows(const float* x, bf16_t* XB, float* SS, int nrows, int gw, int NGW, int lane) {
    constexpr int RB = 8;
    for (int m = gw; m < nrows; m += RB * NGW) {
        f32x4 v[RB][4];
#pragma unroll
        for (int j = 0; j < RB; ++j) if (m + j * NGW < nrows) { const GAS f32x4* xr = (const GAS f32x4*)(x + (size_t)(m + j * NGW) * 1024) + lane;
#pragma unroll
            for (int q = 0; q < 4; ++q) v[j][q] = xr[64 * q]; }
#pragma unroll
        for (int j = 0; j < RB; ++j) if (m + j * NGW < nrows) { const int row = m + j * NGW; float s = 0.f;
#pragma unroll
            for (int q = 0; q < 4; ++q) s += (v[j][q].x * v[j][q].x + v[j][q].y * v[j][q].y) + (v[j][q].z * v[j][q].z + v[j][q].w * v[j][q].w);
            s = wave_sum(s);
            GAS u32x2* o8 = (GAS u32x2*)(XB + (size_t)row * 1024) + lane;
#pragma unroll
            for (int q = 0; q < 4; ++q) { u32x2 w; w.x = pk2(v[j][q].x, v[j][q].y); w.y = pk2(v[j][q].z, v[j][q].w); o8[64 * q] = w; }
            if (lane < 16) SS[(size_t)row * 16 + lane] = lane == 0 ? s : 0.f; }
    }
}
__device__ __forceinline__ void p0_prologue(KP P, lds_u8* lds, int wv) {
    const int tid = opaque_tid(wv), lane = tid & 63, wave = tid >> 6;
    const int bid = opaque_bid(), G = opaque_grid();
    const int gw = bid * NWAVES + wave, NGW = G * NWAVES;
    unsigned char* ws = opaque_ptr(P.ws);
    LAS float* scr = (LAS float*)(lds + wave * 16384);
    bf16_t* WTIN = (bf16_t*)(ws + WS_WTIN); bf16_t* WTUQ = (bf16_t*)(ws + WS_WTUQ); bf16_t* WTUKV = (bf16_t*)(ws + WS_WTUKV); bf16_t* WTOUT = (bf16_t*)(ws + WS_WTOUT);
    constexpr int I_IN = 16 * 77, I_MEM = 16 * 16, I_UQ = 4 * 24, I_UKV = 2 * 32, I_OUT = 16 * 32, I_PAD = 96;
    constexpr int PER_L = I_IN + I_MEM + I_UQ + I_UKV + I_OUT + I_PAD;
    auto decode = [&](int it) -> TItem {
        const int l = it / PER_L; int r = it % PER_L;
        if (r < I_IN) return TItem{P.w_in + (size_t)l * 1024 * D_IN, P.norm_g + l * 1024, WTIN, 1024, D_IN, l * 2560, 0, r}; r -= I_IN;
        if (r < I_MEM) return TItem{P.w_mem_kv + (size_t)l * 1024 * 512, P.mem_norm_g + l * 1024, WTIN, 1024, 512, 5120 + l * 512, 0, r}; r -= I_MEM;
        if (r < I_UQ) return TItem{P.w_uq + (size_t)l * 256 * 768, P.q_norm_g + l * 256, WTUQ, 256, 768, l * 768, 16, r}; r -= I_UQ;
        if (r < I_UKV) return TItem{P.w_ukv + (size_t)l * 128 * 1024, P.kv_norm_g + l * 128, WTUKV, 128, 1024, l * 1024, 8, r}; r -= I_UKV;
        if (r < I_OUT) return TItem{P.w_out + (size_t)l * 1024 * 1024, nullptr, WTOUT, 1024, 1024, l * 1024, 0, r}; r -= I_OUT;
        return TItem{nullptr, nullptr, WTIN, 1024, D_IN, l * 2560 + D_IN, 0, -1 - r};
    };
    constexpr int IB = 3;
    for (int it0 = gw; it0 < 2 * PER_L; it0 += IB * NGW) {
        TItem ti[IB]; float w[IB][32]; f32x4 g0[IB], g1[IB];
#pragma unroll
        for (int j = 0; j < IB; ++j) if (it0 + j * NGW < 2 * PER_L) { ti[j] = decode(it0 + j * NGW); p0_item_load(ti[j], lane, w[j], g0[j], g1[j]); }
#pragma unroll
        for (int j = 0; j < IB; ++j) if (it0 + j * NGW < 2 * PER_L) p0_item_finish(ti[j], lane, w[j], g0[j], g1[j], scr);
    }
    bf16_t* XB = (bf16_t*)(ws + WS_XB); float* SS = (float*)(ws + WS_ROWSS);
    xb_rows(P.x, XB, SS, NTOK, gw, NGW, lane);
    xb_rows(P.mem, XB + (size_t)NTOK * 1024, SS + (size_t)NTOK * 16, BATCH * MEM_TOKENS, gw, NGW, lane);
    {
        f32x2* rope = (f32x2*)(ws + WS_ROPE);
        const float invt[16] = {1.0f, 0.5623413324356079f, 0.3162277638912201f, 0.17782793939113617f, 0.10000000149011612f, 0.05623413249850273f, 0.03162277489900589f, 0.017782794311642647f, 0.009999999776482582f, 0.005623413249850273f, 0.003162277629598975f, 0.0017782794311642647f, 0.0010000000474974513f, 0.000562341301701963f, 0.0003162277571391314f, 0.00017782794020604342f};
        for (int e = bid * NTHREADS + tid; e < NTOK * 16; e += G * NTHREADS) {
            const int t = e >> 4, i = e & 15;
            float inv = invt[0];
#pragma unroll
            for (int k = 1; k < 16; ++k) inv = (i == k) ? invt[k] : inv;
            const float ang = (float)P.pos[t] * inv;
            double r = (double)ang * 0.15915494309189535; r -= rint(r);
            f32x2 cs; cs.x = __builtin_amdgcn_cosf((float)r); cs.y = __builtin_amdgcn_sinf((float)r); rope[e] = cs;
        }
    }
    if (bid == G - 1 && wave == 0) {
        float* SC = (float*)(ws + WS_CTL + CTL_SC);
        for (int l = 0; l < DEPTH; ++l) {
            const float lam_init = 0.8f - 0.6f * expf(-0.3f * (float)l);
            const float* lv = P.dlam + l * 128; const int i = lane & 31;
            float d0 = lane < 32 ? lv[i] * lv[32 + i] : 0.f, d1 = lane < 32 ? lv[64 + i] * lv[96 + i] : 0.f;
            d0 = wave_sum(d0); d1 = wave_sum(d1);
            if (lane == 0) { SC[l * 16 + SC_LAM] = expf(d0) - expf(d1) + lam_init; SC[l * 16 + SC_OSCALE] = 1.0f - lam_init; }
        }
    }
}

#ifndef FX_NT_IMG
#define FX_NT_IMG 0
#endif
#if FX_NT_IMG
#define IMG_STORE(p, v) __builtin_nontemporal_store((v), (GAS u32x4*)(p))
#else
#define IMG_STORE(p, v) (*(GAS u32x4*)(p) = (v))
#endif
__device__ __forceinline__ void store_q_tile(unsigned char* qimg, int nch, int qg, int ft, const f32x16& v, int r32, int hi) {
#pragma unroll
    for (int s = 0; s < 2; ++s) IMG_STORE((u32x4*)(qimg + ((size_t)qg * nch + 2 * (2 * ft + s) + hi) * 512 + r32 * 16), pack8(v, s));
}
__device__ __forceinline__ void store_k_tile(unsigned char* kimg, int nch, int tile, int row64, int ft, const f32x16& v, int hi) {
#pragma unroll
    for (int s = 0; s < 2; ++s) IMG_STORE((u32x4*)(kimg + ((size_t)tile * nch + 2 * (2 * ft + s) + hi) * 1024 + row64 * 16), pack8(v, s));
}
__device__ __forceinline__ void store_v_tile(unsigned char* vimg, int tile, int tg, int dt, const f32x16& v, int r32, int hi) {
#pragma unroll
    for (int s = 0; s < 2; ++s) IMG_STORE((u32x4*)(vimg + ((size_t)tile * 8 + 2 * (2 * tg + s) + hi) * 1024 + (32 * dt + r32) * 16), pack8(v, s));
}
__device__ __forceinline__ void transpose_v64(const bf16_t* src_row  , unsigned char* vimg, int tile, int tg, int r32, int hi) {
    bf16x8 xf[4];
#pragma unroll
    for (int ks = 0; ks < 4; ++ks) xf[ks] = LDG16(src_row + 16 * ks + 8 * hi);
#pragma unroll
    for (int dt = 0; dt < 2; ++dt) {
        f32x16 acc = {};
#pragma unroll
        for (int kk = 0; kk < 2; ++kk) {
            const int ks = 2 * dt + kk;
            bf16x8 id;
#pragma unroll
            for (int j = 0; j < 8; ++j) id[j] = (16 * kk + 8 * hi + j == r32) ? (short)0x3f80 : (short)0;
            acc = MFMA32(xf[ks], id, acc);
        }
        store_v_tile(vimg, tile, tg, dt, acc, r32, hi);
    }
}

__device__ __forceinline__ void p2_mla(KP P, int l, lds_u8* lds, int wv) {
    const int tid = opaque_tid(wv), lane = tid & 63, wave = __builtin_amdgcn_readfirstlane(tid >> 6), r32 = lane & 31, hi = lane >> 5;
    unsigned char* ws = opaque_ptr(P.ws);
    const bf16_t* PROJ = (const bf16_t*)(ws + WS_PROJ);
    const int bid = opaque_bid(), G = opaque_grid();
#if FX_PROBE >= 10
    volatile LAS unsigned* prb = (volatile LAS unsigned*)(lds + 135168 + 64); const bool pon = (bid == 0 && wave == 0 && l == 0);
#define P2S(i) do { if (pon) { const unsigned long long t_ = __builtin_amdgcn_s_memtime(); if (lane == 0) { prb[8 + (i)] += (unsigned)(t_ - pstamp); } pstamp = t_; } } while (0)
    unsigned long long pstamp = __builtin_amdgcn_s_memtime();
#else
#define P2S(i)
#endif
    for (int unit = bid; unit < 256; unit += G) {
        const int h = unit & 7, tb = unit >> 3;
        {
            const unsigned char* wq = ws + WS_WTUQ + (size_t)l * (768 * 256 * 2) + (size_t)h * 49152;
            const unsigned char* wkv = ws + WS_WTUKV + (size_t)l * (1024 * 128 * 2) + (size_t)h * 32768;
            const unsigned lds0 = (unsigned)(uintptr_t)lds;
#pragma unroll 1
            for (int p = wave; p < 80; p += 8) {
                const unsigned char* src = p < 48 ? wq + p * 1024 : wkv + (p - 48) * 1024;
                glds16(src + lane * 16, (unsigned)__builtin_amdgcn_readfirstlane(lds0 + p * 1024));
            }
            if (tid < 192) ((LAS float*)(lds + 81920))[tid] = tid < 96 ? P.qn_g[l * 96 + tid] : P.kn_g[l * 96 + tid - 96];
            asm volatile("s_waitcnt vmcnt(0) lgkmcnt(0)\n\ts_barrier" ::: "memory");
        }
        P2S(0);
        const lds_u8* wql = lds + lane * 16;
        const lds_u8* wkl = lds + 49152 + lane * 16;
        const LAS float* gl = (const LAS float*)(lds + 81920);
#pragma unroll 1
        for (int g = wave; g < 16; g += 8) {
            const int Gi = tb * 16 + g, b = Gi >> 8, qg = Gi & 255, tile = qg >> 1, tg = qg & 1;
            const int T = Gi * 32 + r32;
            const int row64 = 32 * tg + r32, bh = b * 8 + h;
            const bf16_t* prow = PROJ + (size_t)T * PROJ_PITCH;
            const f32x2* cs = (const f32x2*)(ws + WS_ROPE) + (size_t)T * 16;
            bf16x8 xq[16], xkv[8]; u32x2 krw[4]; f32x4 csv[4];
#pragma unroll
            for (int ks = 0; ks < 16; ++ks) xq[ks] = LDG16(prow + OFF_CQ + 16 * ks + 8 * hi);
#pragma unroll
            for (int ks = 0; ks < 8; ++ks) xkv[ks] = LDG16(prow + OFF_CKV + 16 * ks + 8 * hi);
#pragma unroll
            for (int q4 = 0; q4 < 4; ++q4) krw[q4] = *(const GAS u32x2*)(prow + OFF_KR + 8 * q4 + 4 * hi);
#pragma unroll
            for (int q4 = 0; q4 < 2; ++q4) { csv[2 * q4] = *(const GAS f32x4*)(cs + 8 * q4 + 4 * hi); csv[2 * q4 + 1] = *(const GAS f32x4*)(cs + 8 * q4 + 4 * hi + 2); }
            __builtin_amdgcn_sched_barrier(0);
#define P2_ROPE(v) do { _Pragma("unroll") for (int g2 = 0; g2 < 2; ++g2) { const f32x4 a_ = csv[2 * g2], b_ = csv[2 * g2 + 1]; const float c_[4] = {a_.x, a_.z, b_.x, b_.z}, s_[4] = {a_.y, a_.w, b_.y, b_.w}; \
        _Pragma("unroll") for (int e = 0; e < 4; ++e) { const int r = 4 * g2 + e; const float x1 = v[r], x2 = v[r + 8]; v[r] = x1 * c_[e] - x2 * s_[e]; v[r + 8] = x2 * c_[e] + x1 * s_[e]; } } } while (0)
#define P2_GAIN(dst, off) do { _Pragma("unroll") for (int g2 = 0; g2 < 4; ++g2) { const f32x4 w_ = *(const LAS f32x4*)(gl + (off) + 8 * g2 + 4 * hi); dst[4 * g2] = w_.x; dst[4 * g2 + 1] = w_.y; dst[4 * g2 + 2] = w_.z; dst[4 * g2 + 3] = w_.w; } } while (0)
            P2S(1);
            {
                float ssq = 0.f;
#pragma unroll
                for (int ks = 0; ks < 16; ++ks)
#pragma unroll
                    for (int j = 0; j < 8; ++j) { const float f = __uint_as_float((unsigned)(unsigned short)xq[ks][j] << 16); ssq += f * f; }
                const float rstd_q = 1.0f / sqrtf(xsum32(ssq) * (1.f / 256.f) + RMS_EPS);
                f32x16 qa[3]; qa[0] = f32x16{}; qa[1] = f32x16{}; qa[2] = f32x16{};
                {
                    bf16x8 fr[4];
#pragma unroll
                    for (int i = 0; i < 4; ++i) fr[i] = *(const LAS bf16x8*)(wql + i * 1024);
                    __builtin_amdgcn_sched_barrier(0);
#pragma unroll
                    for (int i = 0; i < 48; ++i) { qa[i >> 4] = MFMA32(fr[i & 3], xq[i & 15], qa[i >> 4]); if (i + 4 < 48) fr[i & 3] = *(const LAS bf16x8*)(wql + (i + 4) * 1024); __builtin_amdgcn_sched_barrier(0); }
                }
                P2S(2);
                float ss = sumsq16(qa[0]) + sumsq16(qa[1]) + sumsq16(qa[2]);
                ss = xsum32(ss) * rstd_q * rstd_q;
                const float rn = rstd_q * (LOG2E / sqrtf(96.f)) / sqrtf(ss * (1.f / 96.f) + RMS_EPS);
                unsigned char* qimg = opaque_ptr((unsigned char*)P.out) + OUT_QMLA + (size_t)bh * (256 * 12 * 512);
#pragma unroll
                for (int ft = 0; ft < 3; ++ft) { f32x16 gn; P2_GAIN(gn, 32 * ft);
#pragma unroll
                    for (int r = 0; r < 16; ++r) qa[ft][r] *= rn * gn[r];
                    if (ft == 2) P2_ROPE(qa[2]);
                    store_q_tile(qimg, 12, qg, ft, qa[ft], r32, hi); }
            }
            __builtin_amdgcn_sched_barrier(0);
            P2S(3);
            {
                float sskv = 0.f;
#pragma unroll
                for (int ks = 0; ks < 8; ++ks)
#pragma unroll
                    for (int j = 0; j < 8; ++j) { const float f = __uint_as_float((unsigned)(unsigned short)xkv[ks][j] << 16); sskv += f * f; }
                const float rstd_kv = 1.0f / sqrtf(xsum32(sskv) * (1.f / 128.f) + RMS_EPS);
                f32x16 ka[2], va[2]; ka[0] = f32x16{}; ka[1] = f32x16{}; va[0] = f32x16{}; va[1] = f32x16{};
                {
                    bf16x8 fr[4];
#pragma unroll
                    for (int i = 0; i < 4; ++i) fr[i] = *(const LAS bf16x8*)(wkl + i * 1024);
                    __builtin_amdgcn_sched_barrier(0);
#pragma unroll
                    for (int i = 0; i < 32; ++i) {
                        if (i < 16) ka[i >> 3] = MFMA32(fr[i & 3], xkv[i & 7], ka[i >> 3]); else va[(i >> 3) - 2] = MFMA32(xkv[i & 7], fr[i & 3], va[(i >> 3) - 2]);
                        if (i + 4 < 32) fr[i & 3] = *(const LAS bf16x8*)(wkl + (i + 4) * 1024);
                        __builtin_amdgcn_sched_barrier(0); }
                }
                P2S(5);
                f32x16 kr;
#pragma unroll
                for (int q4 = 0; q4 < 4; ++q4) { kr[4 * q4] = bflo(krw[q4].x); kr[4 * q4 + 1] = bfhi(krw[q4].x); kr[4 * q4 + 2] = bflo(krw[q4].y); kr[4 * q4 + 3] = bfhi(krw[q4].y); }
                const float ss = xsum32(sumsq16(ka[0]) + sumsq16(ka[1])) * rstd_kv * rstd_kv + xsum32(sumsq16(kr));
                const float rk = 1.0f / sqrtf(ss * (1.f / 96.f) + RMS_EPS);
                unsigned char* kimg = opaque_ptr((unsigned char*)P.out) + OUT_KMLA + (size_t)bh * (128 * 12 * 1024);
#pragma unroll
                for (int ft = 0; ft < 2; ++ft) { f32x16 gn; P2_GAIN(gn, 96 + 32 * ft);
#pragma unroll
                    for (int r = 0; r < 16; ++r) ka[ft][r] *= rstd_kv * rk * gn[r];
                    store_k_tile(kimg, 12, tile, row64, ft, ka[ft], hi); }
                f32x16 gn; P2_GAIN(gn, 96 + 64);
#pragma unroll
                for (int r = 0; r < 16; ++r) kr[r] *= rk * gn[r];
                P2_ROPE(kr);
                store_k_tile(kimg, 12, tile, row64, 2, kr, hi);
                P2S(6);
                unsigned char* vimg = ws + WS_VMLA + (size_t)bh * (128 * 8 * 1024);
#pragma unroll
                for (int dt = 0; dt < 2; ++dt) {
#pragma unroll
                    for (int r = 0; r < 16; ++r) va[dt][r] *= __uint_as_float((unsigned)__builtin_amdgcn_ds_bpermute(crow(r, hi) << 2, (int)__float_as_uint(rstd_kv)));
                    store_v_tile(vimg, tile, tg, dt, va[dt], r32, hi); }
            }
            __builtin_amdgcn_sched_barrier(0);
            P2S(4);
#undef P2_ROPE
#undef P2_GAIN
        }
        asm volatile("s_waitcnt lgkmcnt(0)\n\ts_barrier" ::: "memory");
    }
}

template <int VAR>
__device__ __forceinline__ void p2_tokens(KP P, int l, int wv) {
    const int tid = opaque_tid(wv), lane = tid & 63, wave = __builtin_amdgcn_readfirstlane(tid >> 6), r32 = lane & 31, hi = lane >> 5;
    unsigned char* ws = opaque_ptr(P.ws);
    const bf16_t* PROJ = (const bf16_t*)(ws + WS_PROJ);
    const float* SC = (const float*)(ws + WS_CTL + CTL_SC) + l * 16; (void)SC;
    const int tg = wave & 1, hq = wave >> 1;
    const int bid = opaque_bid(), G = opaque_grid();
    for (int blk = bid; blk < NTOK / 64; blk += G) {
        const int b = blk >> 7, tile = blk & 127, qg = tile * 2 + tg;
        const int T = b * SEQ + tile * 64 + 32 * tg + r32;
        const int row64 = 32 * tg + r32;
        const bf16_t* prow = PROJ + (size_t)T * PROJ_PITCH;
        const f32x2* cs = (const f32x2*)(ws + WS_ROPE) + (size_t)T * 16;
        __builtin_amdgcn_sched_barrier(0);
        if (VAR != 3) {
            u32x2 rq[2][4], rk[2][4], rm[2][4]; bf16x8 xv[4]; f32x4 csv[4];
#pragma unroll
            for (int mm = 0; mm < 2; ++mm)
#pragma unroll
                for (int q4 = 0; q4 < 4; ++q4) { rq[mm][q4] = *(const GAS u32x2*)(prow + OFF_DQ + (2 * hq + mm) * 32 + 8 * q4 + 4 * hi); rk[mm][q4] = *(const GAS u32x2*)(prow + OFF_DK + (2 * hq + mm) * 32 + 8 * q4 + 4 * hi);
                                                 rm[mm][q4] = *(const GAS u32x2*)(prow + OFF_MQ + hq * 64 + 32 * mm + 8 * q4 + 4 * hi); }
#pragma unroll
            for (int ks = 0; ks < 4; ++ks) xv[ks] = LDG16(prow + OFF_DV + hq * 64 + 16 * ks + 8 * hi);
#pragma unroll
            for (int q4 = 0; q4 < 2; ++q4) { csv[2 * q4] = *(const GAS f32x4*)(cs + 8 * q4 + 4 * hi); csv[2 * q4 + 1] = *(const GAS f32x4*)(cs + 8 * q4 + 4 * hi + 2); }
            f32x16 gq, gk, gm0, gm1;
            load_gain16(P.dqn_g + l * 32, hi, gq); load_gain16(P.dkn_g + l * 32, hi, gk); load_gain16(P.mqn_g + l * 64, hi, gm0); load_gain16(P.mqn_g + l * 64 + 32, hi, gm1);
            __builtin_amdgcn_sched_barrier(0);
#define P2_UNPK(dst, src) do { _Pragma("unroll") for (int q4 = 0; q4 < 4; ++q4) { dst[4 * q4] = bflo(src[q4].x); dst[4 * q4 + 1] = bfhi(src[q4].x); dst[4 * q4 + 2] = bflo(src[q4].y); dst[4 * q4 + 3] = bfhi(src[q4].y); } } while (0)
#define P2_ROPE(v) do { _Pragma("unroll") for (int g2 = 0; g2 < 2; ++g2) { const f32x4 a_ = csv[2 * g2], b_ = csv[2 * g2 + 1]; const float c_[4] = {a_.x, a_.z, b_.x, b_.z}, s_[4] = {a_.y, a_.w, b_.y, b_.w}; \
        _Pragma("unroll") for (int e = 0; e < 4; ++e) { const int r = 4 * g2 + e; const float x1 = v[r], x2 = v[r + 8]; v[r] = x1 * c_[e] - x2 * s_[e]; v[r + 8] = x2 * c_[e] + x1 * s_[e]; } } } while (0)
            const float dscale = LOG2E / sqrtf(32.f);
#pragma unroll
            for (int mm = 0; mm < 2; ++mm) {
                const int g = 2 * hq + mm;
                f32x16 v;
                P2_UNPK(v, rq[mm]);
                { const float rn = dscale / sqrtf(xsum32(sumsq16(v)) * (1.f / 32.f) + RMS_EPS);
#pragma unroll
                  for (int r = 0; r < 16; ++r) v[r] *= rn * gq[r]; }
                P2_ROPE(v);
                store_q_tile(ws + WS_QDIF + (size_t)(b * 8 + g) * (256 * 4 * 512), 4, qg, 0, v, r32, hi);
                P2_UNPK(v, rk[mm]);
                { const float rn = 1.0f / sqrtf(xsum32(sumsq16(v)) * (1.f / 32.f) + RMS_EPS);
#pragma unroll
                  for (int r = 0; r < 16; ++r) v[r] *= rn * gk[r]; }
                P2_ROPE(v);
                store_k_tile(ws + WS_KDIF + (size_t)(b * 8 + g) * (128 * 4 * 1024), 4, tile, row64, 0, v, hi);
            }
            {
                unsigned char* vimg = ws + WS_VDIF + (size_t)(b * 4 + hq) * (128 * 8 * 1024);
#pragma unroll
                for (int dt = 0; dt < 2; ++dt) { f32x16 acc = {};
#pragma unroll
                    for (int kk = 0; kk < 2; ++kk) { bf16x8 id;
#pragma unroll
                        for (int j = 0; j < 8; ++j) id[j] = (16 * kk + 8 * hi + j == r32) ? (short)0x3f80 : (short)0;
                        acc = MFMA32(xv[2 * dt + kk], id, acc); }
                    store_v_tile(vimg, tile, tg, dt, acc, r32, hi); }
            }
            {
                f32x16 v0, v1; P2_UNPK(v0, rm[0]); P2_UNPK(v1, rm[1]);
                const float rn = (LOG2E * 0.125f) / sqrtf(xsum32(sumsq16(v0) + sumsq16(v1)) * (1.f / 64.f) + RMS_EPS);
#pragma unroll
                for (int r = 0; r < 16; ++r) { v0[r] *= rn * gm0[r]; v1[r] *= rn * gm1[r]; }
                unsigned char* qimg = ws + WS_QMEM + (size_t)(b * 4 + hq) * (256 * 8 * 512);
                store_q_tile(qimg, 8, qg, 0, v0, r32, hi); store_q_tile(qimg, 8, qg, 1, v1, r32, hi);
            }
#undef P2_UNPK
#undef P2_ROPE
        }
    }
    if (l == 0) {
        for (int task = bid * NWAVES + wave; task < 128; task += G * NWAVES) {
            const int h = task & 3, tgm = (task >> 2) & 1, mt = (task >> 3) & 3, b = (task >> 5) & 1, lp = task >> 6;
            const bf16_t* row = (const bf16_t*)(ws + WS_MEMKV) + ((size_t)lp * 512 + b * 256 + mt * 64 + 32 * tgm + r32) * 512;
            f32x16 v0, v1, g0, g1;
            load_tile16(row + h * 64, hi, v0); load_tile16(row + h * 64 + 32, hi, v1);
            load_gain16(P.mkn_g + lp * 64, hi, g0); load_gain16(P.mkn_g + lp * 64 + 32, hi, g1);
            const float rn = 1.0f / sqrtf(xsum32(sumsq16(v0) + sumsq16(v1)) * (1.f / 64.f) + RMS_EPS);
#pragma unroll
            for (int r = 0; r < 16; ++r) { v0[r] *= rn * g0[r]; v1[r] *= rn * g1[r]; }
            unsigned char* kimg = ws + WS_KMEM + (size_t)((lp * 2 + b) * 4 + h) * (4 * 8 * 1024);
            store_k_tile(kimg, 8, mt, 32 * tgm + r32, 0, v0, hi); store_k_tile(kimg, 8, mt, 32 * tgm + r32, 1, v1, hi);
            transpose_v64(row + 256 + h * 64, ws + WS_VMEM + (size_t)((lp * 2 + b) * 4 + h) * (4 * 8 * 1024), mt, tgm, r32, hi);
        }
    }
}

constexpr int ATT_SLOT = 20480;
#define ATT_WAIT_BAR() asm volatile("s_waitcnt vmcnt(0) lgkmcnt(0)\n\ts_barrier" ::: "memory")

struct AttnEpi { int kind;   int ycol; float lam, oscale; const float* subln; const bf16_t* proj; bf16_t* Y; };

#define ATT_SBAR() __builtin_amdgcn_sched_barrier(0)
#if FX_PROBE == 5 || FX_PROBE == 6
#define PROBE_ITEM_BEGIN() unsigned long long pi0_ = 0; if (opaque_bid() == 0 && wid == 0 && NDS != 4) pi0_ = __builtin_amdgcn_s_memtime()
#define PROBE_ITEM_END() if (opaque_bid() == 0 && wid == 0 && NDS != 4) { const unsigned long long pi1_ = __builtin_amdgcn_s_memtime(); if (lane == 0) { prb[NDS == 6 ? 4 : 6] += (unsigned)(pi1_ - pi0_); prb[NDS == 6 ? 5 : 7] += 1u; } }
#else
#define PROBE_ITEM_BEGIN()
#define PROBE_ITEM_END()
#endif
#if FX_PROBE == 2 || FX_PROBE == 3
#define PROBE_ON() (opaque_bid() == 0 && wid == 0)
#define PROBE_BAR_BEGIN() unsigned long long pb0_ = 0; if (PROBE_ON()) pb0_ = __builtin_amdgcn_s_memtime()
#define PROBE_BAR_END() unsigned long long pb1_ = 0; if (PROBE_ON()) { pb1_ = __builtin_amdgcn_s_memtime(); if (lane == 0) prb[0] += (unsigned)(pb1_ - pb0_); }
#define PROBE_ISSUE_END() if (PROBE_ON()) { const unsigned long long pb2_ = __builtin_amdgcn_s_memtime(); if (lane == 0) prb[1] += (unsigned)(pb2_ - pb1_); }
#else
#define PROBE_BAR_BEGIN()
#define PROBE_BAR_END()
#define PROBE_ISSUE_END()
#endif
#ifndef FX_ISSUE_HI
#define FX_ISSUE_HI 1
#endif
#ifndef FX_PRIO
#define FX_PRIO 1
#endif
#ifndef FX_DIFF_PAIR
#define FX_DIFF_PAIR 0
#endif
#ifndef FX_RSMM_ALL
#define FX_RSMM_ALL 0
#endif
#ifndef FX_DMA_AT_BAR
#define FX_DMA_AT_BAR 1
#endif
struct AttIssue { const unsigned char *k0, *k1, *v; unsigned lds0, lane16; int wid, npw; };
template <int NCH, int NMAP>
__device__ __forceinline__ void att_issue(const AttIssue& c, int t, int slot) {
    constexpr int NKP = NMAP * NCH;
#pragma unroll
    for (int i = 0; i < 5; ++i) if (i < c.npw) { const int p = (c.wid & 3) + 4 * i;
        const unsigned char* s = (p < NCH) ? c.k0 + (size_t)t * (NCH * 1024) + p * 1024 : (p < NKP) ? c.k1 + (size_t)t * (NCH * 1024) + (p - NCH) * 1024 : c.v + (size_t)t * 8192 + (p - NKP) * 1024;
        glds16_off(s, c.lane16, (unsigned)__builtin_amdgcn_readfirstlane(c.lds0 + slot * ATT_SLOT + p * 1024)); }
}
template <int NDS, int NMAP, int VAR>
__device__ __forceinline__ void attn_item(f32x16 (&Scur)[2], f32x16 (&Snxt)[2], f32x16& O0, f32x16& O1, f32x16& L, const lds_u8* kb  ,
                                          const lds_u8* vb  , const bf16x8 (&qn)[NDS], int kslot, const AttIssue& ic, int tnext  , bool selrow  , float& lsum_v) {
    constexpr bool RSMM = FX_RSMM_ALL || NDS != 6;
    constexpr int NQ4 = NDS / 2, NG = 3 + NQ4;
    float s0 = 0.f, s1 = 0.f;
    u32x4 pw[2];
    bf16x8 fr[2][NG];
    bf16x8 ones; { const short o1 = selrow ? (short)0x3f80 : (short)0; ones = (bf16x8){o1, o1, o1, o1, o1, o1, o1, o1}; }
#define ATT_VALU(q, lo, hi_) do { _Pragma("unroll") for (int o_ = (lo); o_ < (hi_); ++o_) { \
        if (o_ < 8) { const int r_ = 8 * ((q) & 1) + o_; const float x_ = Scur[(q) >> 1][r_]; Scur[(q) >> 1][r_] = (VAR == 1 || VAR == 7 || VAR >= 11) ? x_ : __builtin_amdgcn_exp2f(x_); } \
        else { const int r_ = 8 * ((q) & 1) + 2 * (o_ - 8); pw[(q) & 1][o_ - 8] = pk2(Scur[(q) >> 1][r_], Scur[(q) >> 1][r_ + 1]); if (!RSMM) { s0 += Scur[(q) >> 1][r_]; s1 += Scur[(q) >> 1][r_ + 1]; } } } } while (0)
#define ATT_PIN(q) do { asm volatile("" : "+v"(Scur[(q) >> 1]), "+v"(pw[(q) & 1])); if (!RSMM) asm volatile("" : "+v"(s0), "+v"(s1)); } while (0)
#define ATT_FRAG(k, g) (VAR == 5 || VAR >= 11 || (VAR == 2 && NDS == 6 && ((g) & 1))) ? qn[0] : ((g) < 2 ? *(const LAS bf16x8*)(vb + (k) * 2048 + (g) * 512) : *(const LAS bf16x8*)(kb + (((k) * NQ4 + (g) - 3) >> 1) * 2048 + (((k) * NQ4 + (g) - 3) & 1) * 512))
#pragma unroll
    for (int g = 0; g < NG; ++g) if (g != 2) fr[0][g] = ATT_FRAG(0, g);
    ATT_SBAR();
    ATT_VALU(0, 0, 12); ATT_PIN(0); ATT_SBAR();
#pragma unroll
    for (int k = 0; k < 4; ++k) {
        const bf16x8 pf = __builtin_bit_cast(bf16x8, pw[k & 1]);
#pragma unroll
        for (int g = 0; g < NG; ++g) {
            constexpr bool NOMM = (VAR == 8 || VAR >= 11);
            if (g == 0) { if (NOMM) asm volatile("" :: "v"(fr[k & 1][0]), "v"(pf)); else O0 = MFMA32(fr[k & 1][0], pf, O0); }
            else if (g == 1) { if (NOMM) asm volatile("" :: "v"(fr[k & 1][1])); else O1 = MFMA32(fr[k & 1][1], pf, O1); }
            else if (g == 2) { if (NOMM || !RSMM) asm volatile("" :: "v"(ones)); else L = MFMA32(ones, pf, L); }
            else { const int j = k * NQ4 + (g - 3), ds = j >> 1, hf = j & 1; if (NOMM) { asm volatile("" :: "v"(fr[k & 1][g])); if (ds == 0) { Snxt[hf] = f32x16{}; asm volatile("" : "+v"(Snxt[hf])); } } else Snxt[hf] = MFMA32(fr[k & 1][g], qn[ds], ds == 0 ? f32x16{} : Snxt[hf]); }
            if (k < 3) { if (g != 2) fr[(k + 1) & 1][g] = ATT_FRAG(k + 1, g); ATT_VALU(k + 1, (g * 12) / NG, ((g + 1) * 12) / NG); ATT_PIN(k + 1); }
            if (g == 0 && k == kslot && tnext >= 0) att_issue<NDS * 2, NMAP>(ic, tnext, tnext & 3);
            ATT_SBAR();
        }
    }
    if (!RSMM) lsum_v += s0 + s1;
#undef ATT_VALU
#undef ATT_PIN
#undef ATT_FRAG
}

template <int DQK, int NMAP, int VAR>
__device__ __forceinline__ void attn_unit(lds_u8* lds, const unsigned char* qimg0, const unsigned char* qimg1, const unsigned char* kimg0, const unsigned char* kimg1,
                                          const unsigned char* vimg, int NT, bool causal, int qb, int rowbase, const AttnEpi& E, int wv) {
    constexpr int NCH = DQK / 8, NKP = NMAP * NCH, NP = NKP + 8, NDS = DQK / 16;
    const int tid = opaque_tid(wv), lane = tid & 63, r32 = lane & 31, hi = lane >> 5;
    const int wid = __builtin_amdgcn_readfirstlane(tid >> 6);
    const unsigned lds0 = (unsigned)(uintptr_t)lds;
#if FX_PRIO
    if ((FX_PRIO == 1) ? (wid >= 4) : (wid < 4)) __builtin_amdgcn_s_setprio(1);
#endif
#if FX_PROBE == 7 || FX_PROBE == 8
    volatile LAS unsigned* prbu = (volatile LAS unsigned*)(lds + 135168 + 64); const bool pu_on = opaque_bid() == 0 && wid == 0; unsigned long long pu0 = 0; if (pu_on) pu0 = __builtin_amdgcn_s_memtime();
#endif
    bf16x8 qf[NMAP][NDS];
#pragma unroll
    for (int m = 0; m < NMAP; ++m)
#pragma unroll
        for (int ds = 0; ds < NDS; ++ds) qf[m][ds] = LDG16((m ? qimg1 : qimg0) + ((size_t)(qb * 8 + wid) * NCH + 2 * ds + hi) * 512 + r32 * 16);
    f32x16 O[NMAP][2], Lacc[1]; float lsum[NMAP];
    const int qw0 = qb * 256 + 32 * wid;
    const int tlast = (VAR == 9 && wid >= 4) ? -1 : causal ? (qw0 + 31) >> 6 : NT - 1;
    const int npw = (FX_ISSUE_HI ? wid >= 4 : wid < 4) ? (NP - (wid & 3) + 3) >> 2 : 0;
    volatile LAS unsigned* prb = (volatile LAS unsigned*)(lds + 135168 + 64); (void)prb;
    AttIssue ic; ic.k0 = kimg0; ic.k1 = kimg1; ic.v = vimg; ic.lds0 = lds0; ic.lane16 = lane * 16; ic.wid = wid; ic.npw = npw;
#define ATT_ISSUE(t, slot) att_issue<NCH, NMAP>(ic, (t), (slot))
#define ATT_SLOTOF(t) ((!FX_DIFF_PAIR && NMAP == 2) ? ((unsigned)(t) & 3u) : ((unsigned)(t) % 6u))
#define ATT_BAR(t) do { PROBE_BAR_BEGIN(); if (VAR == 4 || VAR == 6 || VAR >= 11) { if (VAR == 4) __builtin_amdgcn_s_barrier(); break; } \
        if ((t) < 0 && NT > 2) { if (npw == 5) asm volatile("s_waitcnt vmcnt(10) lgkmcnt(0)\n\ts_barrier" ::: "memory"); else if (npw == 4) asm volatile("s_waitcnt vmcnt(8) lgkmcnt(0)\n\ts_barrier" ::: "memory"); else asm volatile("s_waitcnt lgkmcnt(0)\n\ts_barrier" ::: "memory"); } \
        else ATT_WAIT_BAR(); PROBE_BAR_END(); \
        if ((t) >= 0) { if ((t) + 4 < NT) ATT_ISSUE((t) + 4, ATT_SLOTOF((t) + 4)); if ((t) + 5 < NT) ATT_ISSUE((t) + 5, ATT_SLOTOF((t) + 5)); } PROBE_ISSUE_END(); } while (0)
#define ATT_BAR1(t) do { if ((t) + 2 < NT) { if (npw == 5) asm volatile("s_waitcnt vmcnt(5) lgkmcnt(0)\n\ts_barrier" ::: "memory"); else if (npw == 4) asm volatile("s_waitcnt vmcnt(4) lgkmcnt(0)\n\ts_barrier" ::: "memory"); else asm volatile("s_waitcnt lgkmcnt(0)\n\ts_barrier" ::: "memory"); } \
        else ATT_WAIT_BAR(); if ((t) + 3 < NT) ATT_ISSUE((t) + 3, ((t) + 3) & 3); } while (0)
    const int lane_off = hi * 1024 + r32 * 16;
#define ATT_KB(tk, mk) (lds + ATT_SLOTOF(tk) * ATT_SLOT + (mk) * (NCH * 1024) + lane_off)
#define ATT_VB(tv) (lds + ATT_SLOTOF(tv) * ATT_SLOT + NKP * 1024 + lane_off)
    f32x16 SA[2], SB[2];
    if (!FX_DIFF_PAIR && NMAP == 2) { ATT_ISSUE(0, 0); ATT_ISSUE(1, 1); ATT_BAR1(-1); }
    else { if (VAR != 4 && VAR != 6 && VAR < 11) { ATT_ISSUE(0, 0); ATT_ISSUE(1, 1); if (NT > 2) { ATT_ISSUE(2, 2); ATT_ISSUE(3, 3); } }
           ATT_BAR(-2); }
    { const lds_u8* kb_ = ATT_KB(0, 0);
#pragma unroll
      for (int ds = 0; ds < NDS; ++ds) { SA[0] = MFMA32(*(const LAS bf16x8*)(kb_ + ds * 2048), qf[0][ds], ds == 0 ? f32x16{} : SA[0]); SA[1] = MFMA32(*(const LAS bf16x8*)(kb_ + ds * 2048 + 512), qf[0][ds], ds == 0 ? f32x16{} : SA[1]); } }
    ATT_SBAR();
#define ATT_ITEM(M, MN, CUR, NXT, t, kb_, DOISSUE) do { PROBE_ITEM_BEGIN(); attn_item<NDS, NMAP, VAR>(CUR, NXT, O[M][0], O[M][1], Lacc[0], kb_, ATT_VB(t), qf[MN], wid & 3, ic, -1, NMAP == 1 || ((r32 >> 4) == (M)), lsum[M]); PROBE_ITEM_END(); } while (0)
    u32x2 zraw[2][4];
#define ATT_ZPRE() do { const int lz_ = opaque_tid(wv) & 63; const bf16_t* zr_ = E.proj + (size_t)(rowbase + 32 * wid + (lz_ & 31)) * PROJ_PITCH + OFF_Z + E.ycol + 4 * (lz_ >> 5); \
        _Pragma("unroll") for (int dt_ = 0; dt_ < 2; ++dt_) _Pragma("unroll") for (int g_ = 0; g_ < 4; ++g_) zraw[dt_][g_] = *(const GAS u32x2*)(zr_ + 32 * dt_ + 8 * g_); } while (0)
#define ATT_TAIL(t, S0) do { ATT_ZPRE(); f32x16 T_[2]; T_[0] = S0[0]; T_[1] = S0[1]; const lds_u8* vb_ = ATT_VB(t); const int l2_ = opaque_tid(wv) & 63, hi2_ = l2_ >> 5; const int kq_ = 64 * (t) - (qw0 + (l2_ & 31)); \
        _Pragma("unroll") for (int m_ = 0; m_ < NMAP; ++m_) { asm volatile("" ::: "memory");   \
            if (m_ > 0) { const lds_u8* kb_ = ATT_KB(t, m_); _Pragma("unroll") for (int ds_ = 0; ds_ < NDS; ++ds_) { \
                T_[0] = MFMA32(*(const LAS bf16x8*)(kb_ + ds_ * 2048), qf[m_][ds_], ds_ == 0 ? f32x16{} : T_[0]); T_[1] = MFMA32(*(const LAS bf16x8*)(kb_ + ds_ * 2048 + 512), qf[m_][ds_], ds_ == 0 ? f32x16{} : T_[1]); } } \
            float s_ = 0.f; \
            _Pragma("unroll") for (int r_ = 0; r_ < 16; ++r_) { float x0_ = T_[0][r_], x1_ = T_[1][r_]; \
                if (causal) { const int key_ = kq_ + crow(r_, hi2_); if (key_ > 0) x0_ = -INFINITY; if (key_ + 32 > 0) x1_ = -INFINITY; } \
                x0_ = __builtin_amdgcn_exp2f(x0_); x1_ = __builtin_amdgcn_exp2f(x1_); s_ += x0_ + x1_; T_[0][r_] = x0_; T_[1][r_] = x1_; } \
            lsum[m_] += s_; \
            _Pragma("unroll") for (int k_ = 0; k_ < 4; ++k_) { const bf16x8 pf_ = __builtin_bit_cast(bf16x8, pack8(T_[k_ >> 1], k_ & 1)); \
                O[m_][0] = MFMA32(*(const LAS bf16x8*)(vb_ + k_ * 2048), pf_, O[m_][0]); O[m_][1] = MFMA32(*(const LAS bf16x8*)(vb_ + k_ * 2048 + 512), pf_, O[m_][1]); } } } while (0)
    {
        float zf = 0.f; asm volatile("" : "+v"(zf));
#pragma unroll
        for (int r = 0; r < 16; ++r) { Lacc[0][r] = zf;
#pragma unroll
            for (int m = 0; m < NMAP; ++m) { O[m][0][r] = zf; O[m][1][r] = zf; } }
#pragma unroll
        for (int m = 0; m < NMAP; ++m) lsum[m] = 0.f;
    }
#if FX_PROBE == 7
    if (pu_on) { const unsigned long long t_ = __builtin_amdgcn_s_memtime(); if (lane == 0) { prbu[4] += (unsigned)(t_ - pu0); prbu[5] += 1u; } }
#endif
    if (tlast < 0) { if (!FX_DIFF_PAIR && NMAP == 2) { for (int t = 0; t < NT; ++t) ATT_BAR1(t); } else { for (int t = 0; t < NT; t += 2) ATT_BAR(t); } }
    else if (FX_DIFF_PAIR && NMAP == 2) {
        int t = 0;
        for (; t <= tlast; t += 2) { ATT_BAR(t);
            const int tend = (t + 2 <= tlast) ? t + 2 : tlast;
#pragma unroll 1
            for (int u = t; u < tend; ++u) { ATT_ITEM(0, NMAP - 1, SA, SB, u, ATT_KB(u, NMAP - 1), false); ATT_ITEM(NMAP - 1, 0, SB, SA, u, ATT_KB(u + 1, 0), false); }
            if (tend == tlast) { ATT_TAIL(tlast, SA); t += 2; break; } }
        for (; t < NT; t += 2) ATT_BAR(t);
    }
    else if (NMAP == 2) {
        int t = 0;
        for (; t < tlast; ++t) { ATT_BAR1(t); ATT_ITEM(0, NMAP - 1, SA, SB, t, ATT_KB(t, NMAP - 1), false); ATT_ITEM(NMAP - 1, 0, SB, SA, t, ATT_KB(t + 1, 0), false); }
        ATT_BAR1(t); ATT_TAIL(t, SA);
        for (++t; t < NT; ++t) ATT_BAR1(t);
    } else {
        int t = 0;
        for (; t + 2 <= tlast; t += 2) { ATT_BAR(t); ATT_ITEM(0, 0, SA, SB, t, ATT_KB(t + 1, 0), false); ATT_ITEM(0, 0, SB, SA, t + 1, ATT_KB(t + 2, 0), false); }
        ATT_BAR(t);
        if (t < tlast) { ATT_ITEM(0, 0, SA, SB, t, ATT_KB(t + 1, 0), false); ATT_TAIL(t + 1, SB); }
        else ATT_TAIL(t, SA);
        for (t += 2; t < NT; t += 2) ATT_BAR(t);
    }
#undef ATT_TAIL
#undef ATT_ZPRE
#undef ATT_ITEM
#undef ATT_BAR
#undef ATT_BAR1
#undef ATT_SLOTOF
#undef ATT_KB
#undef ATT_VB
#undef ATT_ISSUE
#if FX_PROBE == 8
    if (pu_on) pu0 = __builtin_amdgcn_s_memtime();
#endif
    const int l3 = opaque_tid(wv) & 63, r32e = l3 & 31, hie = l3 >> 5;
    const int T = rowbase + 32 * wid + r32e;
    f32x16 o[2];
    if (NMAP == 1) {
        const float inv = 1.0f / (xsum32(lsum[0]) + Lacc[0][0]);
#pragma unroll
        for (int dt = 0; dt < 2; ++dt)
#pragma unroll
            for (int r = 0; r < 16; ++r) o[dt][r] = O[0][dt][r] * inv;
    } else {
        const float i0 = 1.0f / (xsum32(lsum[0]) + Lacc[0][0]), i1 = E.lam / (xsum32(lsum[NMAP - 1]) + Lacc[0][8]);
        float ss = 0.f;
#pragma unroll
        for (int dt = 0; dt < 2; ++dt)
#pragma unroll
            for (int r = 0; r < 16; ++r) { const float v = O[0][dt][r] * i0 - O[NMAP - 1][dt][r] * i1; o[dt][r] = v; ss += v * v; }
        const float rn = E.oscale / sqrtf(xsum32(ss) * (1.f / 64.f) + RMS_EPS);
#pragma unroll
        for (int dt = 0; dt < 2; ++dt) { f32x16 g; load_gain16(E.subln + 32 * dt, hie, g);
#pragma unroll
            for (int r = 0; r < 16; ++r) o[dt][r] *= rn * g[r]; }
    }
    const bf16_t* zrow = E.proj + (size_t)T * PROJ_PITCH + OFF_Z + E.ycol;
    bf16_t* yrow = E.Y + (size_t)T * 1024 + E.ycol;
#pragma unroll
    for (int dt = 0; dt < 2; ++dt) {
        f32x16 z;
#pragma unroll
        for (int g = 0; g < 4; ++g) { z[4 * g] = bflo(zraw[dt][g].x); z[4 * g + 1] = bfhi(zraw[dt][g].x); z[4 * g + 2] = bflo(zraw[dt][g].y); z[4 * g + 3] = bfhi(zraw[dt][g].y); }
#pragma unroll
        for (int g = 0; g < 4; ++g) {
            float y[4];
#pragma unroll
            for (int e = 0; e < 4; ++e) { const float zz = z[4 * g + e]; y[e] = o[dt][4 * g + e] * zz / (1.0f + __expf(-zz)); }
            u32x2 w; w.x = pk2(y[0], y[1]); w.y = pk2(y[2], y[3]);
            if (VAR == 0 || lsum[0] == 12345.678f) *(GAS u32x2*)(yrow + 32 * dt + 8 * g + 4 * hie) = w;
        }
    }
#if FX_PRIO
    __builtin_amdgcn_s_setprio(0);
#endif
    asm volatile("s_waitcnt lgkmcnt(0)\n\ts_barrier" ::: "memory");
#if FX_PROBE == 8
    if (pu_on) { const unsigned long long t_ = __builtin_amdgcn_s_memtime(); if (opaque_tid(wv) == 0) { prbu[4] += (unsigned)(t_ - pu0); prbu[5] += 1u; } }
#endif
}

#ifndef FX_VAR
#define FX_VAR 0
#endif
template <int VAR>
__device__ __forceinline__ void p3_attention(KP P, int l, lds_u8* lds, int rep, int wv) {
    unsigned char* ws = opaque_ptr(P.ws);
    const float* SC = (const float*)(ws + WS_CTL + CTL_SC) + l * 16;
    unsigned* qctr = (unsigned*)(ws + WS_CTL + CTL_Q + (2 * l + rep) * 256);
    LAS unsigned* sh = (LAS unsigned*)(lds + 135168 + 16);
    AttnEpi E; E.proj = (const bf16_t*)(ws + WS_PROJ); E.Y = (bf16_t*)(ws + WS_Y); E.lam = __uint_as_float(__builtin_amdgcn_readfirstlane(__float_as_uint(SC[SC_LAM]))); E.oscale = __uint_as_float(__builtin_amdgcn_readfirstlane(__float_as_uint(SC[SC_OSCALE]))); E.subln = P.subln_g + l * 64;
#define ATTN_CALL(D, N) attn_unit<D, N, VAR>
#if FX_PROBE
    if (l == 0 && rep == 0 && opaque_bid() == 0 && opaque_tid(wv) == 0) { volatile LAS unsigned long long* prq = (volatile LAS unsigned long long*)(lds + 135168 + 128); prq[0] = __builtin_amdgcn_s_memtime(); prq[1] = __builtin_amdgcn_s_memrealtime(); }
#endif
    for (;;) {
        if (opaque_tid(wv) == 0) sh[0] = atomicAdd(qctr, 1u);
        __syncthreads();
        const int i = (int)sh[0];
        __syncthreads();
        if (i >= 1024) {
#if FX_PROBE
            if (l == 0 && rep == 0 && opaque_bid() == 0 && opaque_tid(wv) == 0) { volatile LAS unsigned* prb = (volatile LAS unsigned*)(lds + 135168 + 64); volatile LAS unsigned long long* prq = (volatile LAS unsigned long long*)(lds + 135168 + 128);
                prb[2] = (unsigned)(__builtin_amdgcn_s_memtime() - prq[0]); prb[3] = (unsigned)(__builtin_amdgcn_s_memrealtime() - prq[1]); }
#endif
            break; }
        if (i < 768) {
            const int qb = 31 - i / 24, j = i % 24;
            if (j < 8) {
                const int b = j >> 2, h = j & 3;
                E.kind = 1; E.ycol = 512 + h * 64;
                const unsigned char* q0 = ws + WS_QDIF + (size_t)(b * 8 + 2 * h) * (256 * 4 * 512);
                const unsigned char* k0 = ws + WS_KDIF + (size_t)(b * 8 + 2 * h) * (128 * 4 * 1024);
#ifdef FX_NODIFF
                if (rep == 0)
#endif
                ATTN_CALL(32, 2)(lds, q0, q0 + 256 * 4 * 512, k0, k0 + 128 * 4 * 1024, ws + WS_VDIF + (size_t)(b * 4 + h) * (128 * 8 * 1024), 4 * qb + 4, true, qb, b * SEQ + qb * 256, E, wv);
            } else {
                const int bh = j - 8, b = bh >> 3, h = bh & 7;
                E.kind = 0; E.ycol = h * 64;
                const unsigned char* q0 = opaque_ptr((unsigned char*)P.out) + OUT_QMLA + (size_t)bh * (256 * 12 * 512);
                const unsigned char* k0 = opaque_ptr((unsigned char*)P.out) + OUT_KMLA + (size_t)bh * (128 * 12 * 1024);
#ifdef FX_NOMLA
                if (rep == 0)
#endif
                ATTN_CALL(96, 1)(lds, q0, q0, k0, k0, ws + WS_VMLA + (size_t)bh * (128 * 8 * 1024), 4 * qb + 4, true, qb, b * SEQ + qb * 256, E, wv);
            }
        } else {
            const int u = i - 768, s = u >> 5, qb = u & 31, b = s >> 2, h = s & 3;
            E.kind = 2; E.ycol = 768 + h * 64;
            const unsigned char* q0 = ws + WS_QMEM + (size_t)s * (256 * 8 * 512);
            const unsigned char* k0 = ws + WS_KMEM + (size_t)((l * 2 + b) * 4 + h) * (4 * 8 * 1024);
            ATTN_CALL(64, 1)(lds, q0, q0, k0, k0, ws + WS_VMEM + (size_t)((l * 2 + b) * 4 + h) * (4 * 8 * 1024), 4, false, qb, b * SEQ + qb * 256, E, wv);
        }
    }
}

#ifndef FX_G_ALIGN
#define FX_G_ALIGN true
#endif
#ifndef FX_G_SP2
#define FX_G_SP2 true
#endif
struct SchedP1 {
    int G, c, l; bool mem;
    __device__ __forceinline__ bool next(int i, pg8::Unit& u) const {
        const long L = (long)i * G + c;
        if (L < 640) { const int w0 = (int)L, wgid = (w0 % 8) * 80 + w0 / 8; const int gid = wgid / 80, rem = wgid % 80; u.pm = gid * 8 + (rem % 8); u.pn = rem / 8 + 10 * l; return true; }
        if (mem && L < 648) { const int k = (int)L - 640; u.pm = 64 + (k & 1); u.pn = 20 + (k >> 1); return true; }
        return false;
    }
    __device__ __forceinline__ void a_ready(const pg8::Unit&) const {}
    __device__ __forceinline__ void done(const pg8::Unit&) const {}
};
struct EpiProj {
    static constexpr bool PERM = true, AFTER_DRAIN = false;
    bf16_t* proj; bf16_t* memkv; const float* rowss; int l;
    __device__ __forceinline__ void operator()(const pg8::f32x4 (&acc)[2][2][4][2], const pg8::Unit& u, int wr, int wc, int fr, int fq) const {
        bf16_t* base; int ldc, row0, colt;
        if (u.pm < 64) { base = proj; ldc = PROJ_PITCH; row0 = u.pm * 256; colt = (u.pn - 10 * l) * 256; }
        else { const int k = u.pn - 20; base = memkv + (size_t)(k >> 1) * 512 * 512; ldc = 512; row0 = (u.pm - 64) * 256; colt = (k & 1) * 256; }
        row0 += wr * 64 + fr; const int col0 = colt + wc * 32 + 8 * fq;
        const float* ssp = rowss + (size_t)(u.pm * 256 + wr * 64 + fr) * 16 + 4 * fq;
        pg8::f32x4 q4[2][4]; float rs[2][4];
#pragma unroll
        for (int ai = 0; ai < 2; ++ai)
#pragma unroll
            for (int m = 0; m < 4; ++m) q4[ai][m] = *(const GAS pg8::f32x4*)(ssp + (size_t)(ai * 128 + m * 16) * 16);
        __builtin_amdgcn_sched_barrier(0);
#pragma unroll
        for (int ai = 0; ai < 2; ++ai)
#pragma unroll
            for (int m = 0; m < 4; ++m) { float ss = (q4[ai][m][0] + q4[ai][m][1]) + (q4[ai][m][2] + q4[ai][m][3]); ss = xsum16_32(ss); rs[ai][m] = 1.0f / sqrtf(ss * (1.f / 1024.f) + RMS_EPS); }
        __builtin_amdgcn_sched_barrier(0);
#pragma unroll
        for (int ai = 0; ai < 2; ++ai)
#pragma unroll
            for (int m = 0; m < 4; ++m) { bf16_t* rowp = base + (size_t)(row0 + ai * 128 + m * 16) * ldc + col0;
#pragma unroll
                for (int bj = 0; bj < 2; ++bj) { const pg8::f32x4 v0 = acc[ai][bj][m][0] * rs[ai][m], v1 = acc[ai][bj][m][1] * rs[ai][m];
                    u32x4 w; w.x = pk2(v0[0], v0[1]); w.y = pk2(v0[2], v0[3]); w.z = pk2(v1[0], v1[1]); w.w = pk2(v1[2], v1[3]);
                    *(GAS u32x4*)(rowp + bj * 128) = w; } }
    }
};
#ifndef FX_NT_EPI
#define FX_NT_EPI 0
#endif
struct EpiResid {
    static constexpr bool PERM = true, AFTER_DRAIN = false;
    const float* basef; const bf16_t* baseh; float* out; bf16_t* xb; float* rowss;
    template<bool H>
    __device__ __forceinline__ void run(const pg8::f32x4 (&acc)[2][2][4][2], const pg8::Unit& u, int wr, int wc, int fr, int fq) const {
        const int col0 = u.pn * 256 + wc * 32 + 8 * fq;
#pragma unroll
        for (int ai = 0; ai < 2; ++ai) {
            pg8::f32x4 bs[4][2][2];
            if constexpr (H) {
                u32x4 hb[4][2];
#pragma unroll
                for (int m = 0; m < 4; ++m) { const size_t off = (size_t)(u.pm * 256 + ai * 128 + wr * 64 + m * 16 + fr) * 1024 + col0;
#pragma unroll
                    for (int bj = 0; bj < 2; ++bj) hb[m][bj] = *(const GAS u32x4*)(baseh + off + bj * 128); }
                __builtin_amdgcn_sched_barrier(0);
#pragma unroll
                for (int m = 0; m < 4; ++m)
#pragma unroll
                    for (int bj = 0; bj < 2; ++bj) { const u32x4 w = hb[m][bj];
                        bs[m][bj][0][0] = __uint_as_float(w.x << 16); bs[m][bj][0][1] = __uint_as_float(w.x & 0xffff0000u); bs[m][bj][0][2] = __uint_as_float(w.y << 16); bs[m][bj][0][3] = __uint_as_float(w.y & 0xffff0000u);
                        bs[m][bj][1][0] = __uint_as_float(w.z << 16); bs[m][bj][1][1] = __uint_as_float(w.z & 0xffff0000u); bs[m][bj][1][2] = __uint_as_float(w.w << 16); bs[m][bj][1][3] = __uint_as_float(w.w & 0xffff0000u); }
            } else {
#pragma unroll
                for (int m = 0; m < 4; ++m) { const size_t off = (size_t)(u.pm * 256 + ai * 128 + wr * 64 + m * 16 + fr) * 1024 + col0;
#pragma unroll
                    for (int bj = 0; bj < 2; ++bj) { bs[m][bj][0] = *(const GAS pg8::f32x4*)(basef + off + bj * 128); bs[m][bj][1] = *(const GAS pg8::f32x4*)(basef + off + bj * 128 + 4); } }
                __builtin_amdgcn_sched_barrier(0);
            }
#pragma unroll
            for (int m = 0; m < 4; ++m) { const int row = u.pm * 256 + ai * 128 + wr * 64 + m * 16 + fr; const size_t off = (size_t)row * 1024 + col0; float ss = 0.f;
#pragma unroll
                for (int bj = 0; bj < 2; ++bj) {
                    const pg8::f32x4 o0 = bs[m][bj][0] + acc[ai][bj][m][0], o1 = bs[m][bj][1] + acc[ai][bj][m][1];
                    if (out) { *(GAS pg8::f32x4*)(out + off + bj * 128) = o0; *(GAS pg8::f32x4*)(out + off + bj * 128 + 4) = o1; }
                    if (xb) { ss += ((o0[0] * o0[0] + o0[1] * o0[1]) + (o0[2] * o0[2] + o0[3] * o0[3])) + ((o1[0] * o1[0] + o1[1] * o1[1]) + (o1[2] * o1[2] + o1[3] * o1[3]));
                        u32x4 w; w.x = pk2(o0[0], o0[1]); w.y = pk2(o0[2], o0[3]); w.z = pk2(o1[0], o1[1]); w.w = pk2(o1[2], o1[3]); *(GAS u32x4*)(xb + off + bj * 128) = w; } }
                if (xb) { ss = xsum16_32(ss); if (fq == 0) *(GAS float*)(rowss + (size_t)row * 16 + 4 * u.pn + wc) = ss; } }
            __builtin_amdgcn_sched_barrier(0);
        }
    }
    __device__ __forceinline__ void operator()(const pg8::f32x4 (&acc)[2][2][4][2], const pg8::Unit& u, int wr, int wc, int fr, int fq) const {
        if (baseh) run<true>(acc, u, wr, wc, fr, fq); else run<false>(acc, u, wr, wc, fr, fq);
    }
};

__device__ __forceinline__ void p1_inproj(KP P, int l, lds_u8* lds, int wv) {
    unsigned char* ws = opaque_ptr(P.ws);
    pg8::Gemm g{(const pg8::bf16_t*)(ws + WS_XB), (const pg8::bf16_t*)(ws + WS_WTIN), 16896, 6144, 1024};
    SchedP1 S{opaque_grid(), opaque_bid(), l, l == 0};
    EpiProj E{(bf16_t*)(ws + WS_PROJ), (bf16_t*)(ws + WS_MEMKV), (const float*)(ws + WS_ROWSS), l};
    pg8::gemm_phase<EpiProj, SchedP1, FX_G_ALIGN, FX_G_SP2>(lds, g, S, E, wv);
}
__device__ __forceinline__ void p4_outproj(KP P, int l, lds_u8* lds, int wv) {
    unsigned char* ws = opaque_ptr(P.ws);
    pg8::Gemm g{(const pg8::bf16_t*)(ws + WS_Y), (const pg8::bf16_t*)(ws + WS_WTOUT) + (size_t)l * 1024 * 1024, NTOK, 1024, 1024};
    pg8::StaticOrder S; S.init(NTOK, 1024, opaque_grid(), opaque_bid());
    const bool last = l + 1 == DEPTH;
    EpiResid E{l == 0 ? P.x : nullptr, l == 0 ? nullptr : (const bf16_t*)(ws + WS_XB), last ? P.out : nullptr, last ? nullptr : (bf16_t*)(ws + WS_XB), (float*)(ws + WS_ROWSS)};
    pg8::gemm_phase<EpiResid, pg8::StaticOrder, FX_G_ALIGN, FX_G_SP2>(lds, g, S, E, wv);
}

constexpr int LDS_BYTES = 147456;
constexpr int LDS_MISC = 135168;
#ifndef FX_CG_ONLY
#define FX_CG_ONLY 0
#endif
__global__ void __launch_bounds__(NTHREADS, 2) fwd_kernel(Params P_arg) {
    extern __shared__ __attribute__((aligned(16))) unsigned char lds_raw[];
    lds_u8* lds = (lds_u8*)lds_raw;
#ifndef FX_NOCG
    cg::grid_group grid = cg::this_grid();
#endif
    const int wv = __builtin_amdgcn_readfirstlane(threadIdx.x >> 6);
    volatile LAS unsigned* misc = (volatile LAS unsigned*)(lds + LDS_MISC);
    if (threadIdx.x < 32) misc[threadIdx.x] = 0u;
    __syncthreads();
    xb::XcdBarrier bar = xb::xcd_barrier_post((unsigned*)(P_arg.ws + WS_CTL + CTL_BAR), misc + 8);
#ifndef FX_DUP
#define FX_DUP -1
#endif
#ifndef FX_VAR
#define FX_VAR 0
#endif
#ifndef FX_XBAR
#define FX_XBAR 0
#endif
#define FX_KP() (*launder_kp())
#define FX_BAR() xb::xcd_barrier(bar, wv)
    p0_prologue(FX_KP(), lds, wv);
#ifndef FX_NOCG
    grid.sync();
#else
    FX_BAR();
#endif
    if (FX_DUP == 0) { p0_prologue(FX_KP(), lds, wv); FX_BAR(); }
    for (int xb_ = 0; xb_ < FX_XBAR; ++xb_) FX_BAR();
#pragma unroll 1
    for (int l = 0; l < DEPTH; ++l) {
#ifndef FX_SKIP1
        p1_inproj(FX_KP(), l, lds, wv);
#endif
        FX_BAR();
        if (FX_DUP == 1) { p1_inproj(FX_KP(), l, lds, wv); FX_BAR(); }
        if (FX_DUP == 2) { if (FX_VAR != 11) p2_mla(FX_KP(), l, lds, wv); if (FX_VAR != 10) p2_tokens<0>(FX_KP(), l, wv); FX_BAR(); }
#ifndef FX_SKIP2
        p2_mla(FX_KP(), l, lds, wv);
        p2_tokens<0>(FX_KP(), l, wv);
#endif
        FX_BAR();
#ifndef FX_SKIP3
        p3_attention<0>(FX_KP(), l, lds, 0, wv);
#endif
        FX_BAR();
        if (FX_DUP == 3) { p3_attention<FX_VAR>(FX_KP(), l, lds, 1, wv); FX_BAR(); }
#ifndef FX_SKIP4
        p4_outproj(FX_KP(), l, lds, wv);
#endif
        if (l + 1 < DEPTH) FX_BAR();
        if (FX_DUP == 4 && l == 0) { p4_outproj(FX_KP(), l, lds, wv); FX_BAR(); }
    }
#if FX_PROBE
    if (opaque_bid() == 0 && opaque_tid(wv) == 0) {
        volatile LAS unsigned* prb = (volatile LAS unsigned*)(lds + 135168 + 64);
        unsigned ticks = 0;
        if (FX_PROBE == 1) ticks = (unsigned)((unsigned long long)prb[2] * 1000ull / (prb[3] ? prb[3] : 1u));
        if (FX_PROBE == 2) ticks = (unsigned)((unsigned long long)prb[0] * 10000ull / (prb[2] ? prb[2] : 1u));
        if (FX_PROBE == 3) ticks = (unsigned)((unsigned long long)prb[1] * 10000ull / (prb[2] ? prb[2] : 1u));
        if (FX_PROBE == 4) ticks = prb[3] / 10;
        if (FX_PROBE == 7 || FX_PROBE == 8) ticks = (unsigned)((unsigned long long)prb[4] / (prb[5] ? prb[5] : 1u));
        if (FX_PROBE == 5) ticks = (unsigned)((unsigned long long)prb[4] * 10ull / (prb[5] ? prb[5] : 1u));
        if (FX_PROBE == 6) ticks = (unsigned)((unsigned long long)prb[6] * 10ull / (prb[7] ? prb[7] : 1u));
        if (FX_PROBE >= 10) ticks = prb[8 + FX_PROBE - 10] / 10;
        const unsigned long long r0 = __builtin_amdgcn_s_memrealtime();
        while (__builtin_amdgcn_s_memrealtime() - r0 < (unsigned long long)ticks) __builtin_amdgcn_s_sleep(8);
    }
#endif
}
}

static void fill_params(fx::Params& P, void* const* d_in, void* d_out, void* d_ws) {
    P.x = (const float*)d_in[0]; P.mem = (const float*)d_in[1]; P.pos = (const int*)d_in[2]; P.norm_g = (const float*)d_in[3]; P.w_in = (const float*)d_in[4];
    P.q_norm_g = (const float*)d_in[5]; P.kv_norm_g = (const float*)d_in[6]; P.w_uq = (const float*)d_in[7]; P.w_ukv = (const float*)d_in[8];
    P.qn_g = (const float*)d_in[9]; P.kn_g = (const float*)d_in[10]; P.dqn_g = (const float*)d_in[11]; P.dkn_g = (const float*)d_in[12];
    P.dlam = (const float*)d_in[13]; P.subln_g = (const float*)d_in[14]; P.mem_norm_g = (const float*)d_in[15]; P.w_mem_kv = (const float*)d_in[16];
    P.mqn_g = (const float*)d_in[17]; P.mkn_g = (const float*)d_in[18]; P.w_out = (const float*)d_in[19];
    P.out = (float*)d_out; P.ws = (unsigned char*)d_ws;
}

extern "C" void kernel_launch(void* const* d_in, const int* in_sizes, int n_in, void* d_out, int out_size, void* d_ws, size_t ws_size, hipStream_t stream) {
    static int grid_blocks = 0;
    if (!grid_blocks) {
        if (n_in != 20 || out_size != NTOK * D_MODEL || ws_size < fx::WS_END) { fprintf(stderr, "kernel_launch: unexpected shapes (n_in %d out %d ws %zu)\n", n_in, out_size, ws_size); grid_blocks = -1; return; }
        if (hipFuncSetAttribute((const void*)fx::fwd_kernel, hipFuncAttributeMaxDynamicSharedMemorySize, fx::LDS_BYTES) != hipSuccess) { fprintf(stderr, "kernel_launch: hipFuncSetAttribute failed\n"); grid_blocks = -1; return; }
        int dev = 0, cus = 0, per_cu = 0;
        (void)hipGetDevice(&dev);
        (void)hipDeviceGetAttribute(&cus, hipDeviceAttributeMultiprocessorCount, dev);
        (void)hipOccupancyMaxActiveBlocksPerMultiprocessor(&per_cu, (const void*)fx::fwd_kernel, fx::NTHREADS, fx::LDS_BYTES);
        if (per_cu < 1 || cus < 1) { fprintf(stderr, "kernel_launch: occupancy query says %d blocks/CU on %d CUs\n", per_cu, cus); grid_blocks = -1; return; }
        grid_blocks = cus;
        fprintf(stderr, "kernel_launch: grid %d (cus %d, per_cu %d)\n", grid_blocks, cus, per_cu);
    }
    if (grid_blocks < 0) return;
    (void)hipMemsetAsync((char*)d_ws + fx::WS_CTL, 0, fx::CTL_ZERO_BYTES, stream);
    fx::Params P{}; fill_params(P, d_in, d_out, d_ws); P.ph_lo = 0; P.ph_hi = 1;
    void* args[] = {&P};
#ifndef FX_NOCG
    const hipError_t e = hipLaunchCooperativeKernel((const void*)fx::fwd_kernel, dim3(grid_blocks), dim3(fx::NTHREADS), args, fx::LDS_BYTES, stream);
#else
    (void)args; hipLaunchKernelGGL(fx::fwd_kernel, dim3(grid_blocks), dim3(fx::NTHREADS), fx::LDS_BYTES, stream, P); const hipError_t e = hipPeekAtLastError();
#endif
    if (e != hipSuccess) fprintf(stderr, "kernel_launch: cooperative launch failed: %s (grid %d)\n", hipGetErrorString(e), grid_blocks);
}
```

```cpp
#include <hip/hip_runtime.h>
#include <hip/hip_bf16.h>
#include <hip/hip_cooperative_groups.h>
namespace cg = cooperative_groups;
#include <cstdio>
#include <cstdint>
#include <cmath>

constexpr int D_MODEL = 1024, BATCH = 2, SEQ = 8192, DEPTH = 2, MEM_TOKENS = 256;
constexpr int NTOK = BATCH * SEQ;
constexpr float RMS_EPS = 1e-6f;
constexpr int MLA_HEADS = 8, Q_LORA = 256, KV_LORA = 128, MLA_NOPE = 64, MLA_ROPE = 32, MLA_QK = 96, MLA_V = 64;
constexpr int DIFF_HEADS = 4, DIFF_D = 32, DIFF_V = 64;
constexpr int MEM_HEADS = 4, MEM_D = 64;
constexpr int D_MIX = 1024, D_IN = 2464;
constexpr int OFF_CQ = 0, OFF_CKV = 256, OFF_KR = 384, OFF_DQ = 416, OFF_DK = 672, OFF_DV = 928, OFF_MQ = 1184, OFF_Z = 1440;

#define FX_P1B_SP2ALT 1

namespace pg8 {
#define PG8_LAS __attribute__((address_space(3)))
typedef unsigned short bf16_t;
typedef short bf16x8 __attribute__((ext_vector_type(8)));
typedef float f32x4 __attribute__((ext_vector_type(4)));
typedef unsigned u32x4 __attribute__((ext_vector_type(4)));
constexpr int BM = 256, BK = 64, HALF = 128, HTB = HALF * BK * 2  , STAGE_BYTES = 8 * HTB, NXCD = 8, WGM = 8;

__host__ __device__ __forceinline__ int lds_byte(int r, int c) { const int st = (r >> 4) * 2 + (c >> 5), rr = r & 15, cc = c & 31, ob = rr * 64 + cc * 2; return st * 1024 + (ob ^ (((ob >> 9) & 1) << 5)); }
__host__ __device__ __forceinline__ void stage_rc(int b, int& R, int& C) { const int st = b / 1024, sb = b % 1024, swz = sb ^ (((sb >> 9) & 1) << 5); R = (st >> 1) * 16 + swz / 64; C = (st & 1) * 32 + (swz % 64) / 2; }
__host__ __device__ __forceinline__ int perm32(int rho) { const int n = rho >> 4, i = rho & 15; return 8 * (i >> 2) + 4 * n + (i & 3); }

struct Unit { int pm, pn; };
struct Gemm { const bf16_t* A; const bf16_t* Bt; int M, N, K; };

struct StaticOrder {
    int nM, nN, nwg, G, c;
    __host__ __device__ void init(int M, int N, int G_, int c_) { nM = M / BM; nN = N / BM; nwg = nM * nN; G = G_; c = c_; }
    __host__ __device__ bool next(int i, Unit& u) const {
        const long L = (long)i * G + c; if (L >= nwg) return false;
        int wgid = (int)L; { const int q = nwg / NXCD, r = nwg % NXCD, xcd = wgid % NXCD, off = wgid / NXCD; wgid = (xcd < r ? xcd * (q + 1) : r * (q + 1) + (xcd - r) * q) + off; }
        const int nig = WGM * nN, gid = wgid / nig, fm = gid * WGM, gsz = (nM - fm) < WGM ? (nM - fm) : WGM;
        u.pm = fm + ((wgid % nig) % gsz); u.pn = (wgid % nig) / gsz; return true;
    }
    __device__ __forceinline__ void a_ready(const Unit&) const {}
    __device__ __forceinline__ void done(const Unit&) const {}
};


template <class Epi, class Sched, bool ALIGN_EPI = false, bool SP2 = false>
__device__ __forceinline__ void gemm_phase(PG8_LAS unsigned char* lds, const Gemm g, const Sched& S, const Epi& E, int wv) {
    int lane_; asm volatile("v_mbcnt_lo_u32_b32 %0, -1, 0\n\tv_mbcnt_hi_u32_b32 %0, -1, %0" : "=v"(lane_)); asm volatile("" : "+s"(wv)); const int tid = (wv << 6) | lane_; const int wid = __builtin_amdgcn_readfirstlane(tid >> 6), lane = tid & 63, wr = wid >> 2, wc = wid & 3, fr = lane & 15, fq = lane >> 4;
    const int K = g.K, nt = K / BK;
    unsigned voffA[2], voffB[2];
#pragma unroll
    for (int i = 0; i < 2; ++i) { int R, C; stage_rc(tid * 16 + i * 8192, R, C); const int Rb = Epi::PERM ? ((R & ~31) + perm32(R & 31)) : R;
        voffA[i] = (unsigned)(R * K + C) * 2u; voffB[i] = (unsigned)(Rb * K + C) * 2u; }
    const size_t kstep = (size_t)(BK * 2);
    const size_t hstep = (size_t)HALF * K * 2;
    const size_t tstep = 2 * hstep;
    const unsigned ldsw = (unsigned)wid * 1024u;
    const int aoff = lds_byte(wr * 64 + fr, fq * 8), boff = lds_byte(wc * 32 + fr, fq * 8);
#define PG8_SA(b, h) (((b) * 2 + (h)) * HTB)
#define PG8_SB(b, h) ((4 + (b) * 2 + (h)) * HTB)
#define PG8_STAGE(bufoff, gbase, voff) do { _Pragma("unroll") for (int _i = 0; _i < 2; ++_i) \
        __builtin_amdgcn_global_load_lds((const unsigned*)((const char*)(gbase) + (voff)[_i]), (PG8_LAS unsigned*)(lds + (bufoff) + ldsw + _i * 8192), 16, 0, 0); } while (0)
#define PG8_LDA(dst, b, h) do { _Pragma("unroll") for (int m = 0; m < 4; ++m) _Pragma("unroll") for (int k = 0; k < 2; ++k) dst[m][k] = *(const PG8_LAS bf16x8*)(lds + PG8_SA(b, h) + aoff + m * 2048 + k * 1024); } while (0)
#define PG8_LDB(dst, b, h) do { _Pragma("unroll") for (int n = 0; n < 2; ++n) _Pragma("unroll") for (int k = 0; k < 2; ++k) dst[n][k] = *(const PG8_LAS bf16x8*)(lds + PG8_SB(b, h) + boff + n * 2048 + k * 1024); } while (0)
#define PG8_MMA(ai, bj, At, Bt) do { __builtin_amdgcn_s_setprio(1); _Pragma("unroll") for (int m = 0; m < 4; ++m) _Pragma("unroll") for (int n = 0; n < 2; ++n) _Pragma("unroll") for (int k = 0; k < 2; ++k) \
        acc[ai][bj][m][n] = __builtin_amdgcn_mfma_f32_16x16x32_bf16(Bt[n][k], At[m][k], acc[ai][bj][m][n], 0, 0, 0); __builtin_amdgcn_s_setprio(0); } while (0)
#define PG8_WAIT_V(n) asm volatile("s_waitcnt vmcnt(" #n ")" ::: "memory")
#define PG8_WAIT_L(n) asm volatile("s_waitcnt lgkmcnt(" #n ")" ::: "memory")
#define PG8_BAR __builtin_amdgcn_s_barrier()
#define PG8_SCHED __builtin_amdgcn_sched_barrier(0)
    Unit cur, nxt; int ui = 0;
    if (!S.next(0, cur)) return;
    f32x4 acc[2][2][4][2];
#pragma unroll
    for (int a = 0; a < 2; ++a)
#pragma unroll
        for (int b = 0; b < 2; ++b)
#pragma unroll
            for (int m = 0; m < 4; ++m)
#pragma unroll
                for (int n = 0; n < 2; ++n) acc[a][b][m][n] = (f32x4){0.f, 0.f, 0.f, 0.f};
    bf16x8 At[4][2], B0[2][2], B1[2][2];
    const char* cA = (const char*)g.A + (size_t)cur.pm * tstep; const char* cB = (const char*)g.Bt + (size_t)cur.pn * tstep;
    S.a_ready(cur);
    if constexpr (SP2) {
        PG8_STAGE(PG8_SB(0, 0), cB, voffB); PG8_STAGE(PG8_SB(0, 1), cB + hstep, voffB); PG8_STAGE(PG8_SA(0, 0), cA, voffA); PG8_STAGE(PG8_SA(0, 1), cA + hstep, voffA);
        if (wr == 1) PG8_BAR;
        PG8_WAIT_V(2); PG8_BAR;
        PG8_STAGE(PG8_SB(1, 0), cB + kstep, voffB); PG8_STAGE(PG8_SA(1, 0), cA + kstep, voffA); PG8_STAGE(PG8_SB(1, 1), cB + hstep + kstep, voffB);
        PG8_WAIT_V(6); PG8_BAR;
    } else {
        PG8_STAGE(PG8_SB(0, 0), cB, voffB); PG8_STAGE(PG8_SA(0, 0), cA, voffA); PG8_STAGE(PG8_SB(0, 1), cB + hstep, voffB); PG8_STAGE(PG8_SA(0, 1), cA + hstep, voffA);
        if (wr == 1) PG8_BAR;
        PG8_WAIT_V(4); PG8_BAR;
        PG8_STAGE(PG8_SB(1, 0), cB + kstep, voffB); PG8_STAGE(PG8_SA(1, 0), cA + kstep, voffA); PG8_STAGE(PG8_SB(1, 1), cB + hstep + kstep, voffB);
        PG8_WAIT_V(6); PG8_BAR;
    }
    for (;;) {
        const bool has_next = S.next(ui + 1, nxt);
        const char* nA = has_next ? (const char*)g.A + (size_t)nxt.pm * tstep : cA; const char* nB = has_next ? (const char*)g.Bt + (size_t)nxt.pn * tstep : cB;
        for (int t = 0; t < nt; t += 2) {
            const bool last = (t == nt - 2);
            const char* a1 = cA + (size_t)(t + 1) * kstep;
            const char* a2 = last ? nA : cA + (size_t)(t + 2) * kstep; const char* b2 = last ? nB : cB + (size_t)(t + 2) * kstep;
            const char* a3 = a2 + kstep; const char* b3 = b2 + kstep;
            if (last && has_next) S.a_ready(nxt);
            if constexpr (SP2) {
            PG8_LDB(B0, 0, 0); PG8_LDB(B1, 0, 1); PG8_SCHED; PG8_LDA(At, 0, 0); PG8_STAGE(PG8_SA(1, 1), a1 + hstep, voffA);
            PG8_WAIT_V(8); PG8_WAIT_L(0); PG8_BAR; PG8_MMA(0, 0, At, B0); PG8_MMA(0, 1, At, B1); PG8_BAR; PG8_SCHED;
            PG8_LDA(At, 0, 1); PG8_STAGE(PG8_SB(0, 0), b2, voffB); PG8_STAGE(PG8_SB(0, 1), b2 + hstep, voffB); PG8_STAGE(PG8_SA(0, 0), a2, voffA);
            PG8_WAIT_V(8); PG8_WAIT_L(0); PG8_BAR; PG8_MMA(1, 0, At, B0); PG8_MMA(1, 1, At, B1); PG8_BAR; PG8_SCHED;
            PG8_LDB(B0, 1, 0); PG8_LDB(B1, 1, 1); PG8_SCHED; PG8_LDA(At, 1, 0); PG8_STAGE(PG8_SA(0, 1), a2 + hstep, voffA);
            PG8_WAIT_V(8); PG8_WAIT_L(0); PG8_BAR; PG8_MMA(0, 0, At, B0); PG8_MMA(0, 1, At, B1); PG8_BAR; PG8_SCHED;
            PG8_LDA(At, 1, 1); PG8_STAGE(PG8_SB(1, 0), b3, voffB); PG8_STAGE(PG8_SB(1, 1), b3 + hstep, voffB); PG8_STAGE(PG8_SA(1, 0), a3, voffA);
            PG8_WAIT_V(8); PG8_WAIT_L(0); PG8_BAR; PG8_MMA(1, 0, At, B0); PG8_MMA(1, 1, At, B1); PG8_BAR; PG8_SCHED;
            } else {
            PG8_LDB(B0, 0, 0); PG8_SCHED; PG8_LDA(At, 0, 0); PG8_STAGE(PG8_SA(1, 1), a1 + hstep, voffA);
            PG8_WAIT_L(8); PG8_BAR; PG8_WAIT_L(0); PG8_MMA(0, 0, At, B0); PG8_BAR; PG8_SCHED;
            PG8_LDB(B1, 0, 1); PG8_STAGE(PG8_SB(0, 0), b2, voffB);
            PG8_BAR; PG8_WAIT_L(0); PG8_MMA(0, 1, At, B1); PG8_BAR;
            PG8_LDA(At, 0, 1); PG8_STAGE(PG8_SA(0, 0), a2, voffA);
            PG8_BAR; PG8_WAIT_L(0); PG8_MMA(1, 0, At, B0); PG8_BAR; PG8_SCHED;
            PG8_STAGE(PG8_SB(0, 1), b2 + hstep, voffB);
            PG8_WAIT_V(6); PG8_BAR; PG8_MMA(1, 1, At, B1); PG8_BAR;
            PG8_LDB(B0, 1, 0); PG8_SCHED; PG8_LDA(At, 1, 0); PG8_STAGE(PG8_SA(0, 1), a2 + hstep, voffA);
            PG8_WAIT_L(8); PG8_BAR; PG8_WAIT_L(0); PG8_MMA(0, 0, At, B0); PG8_BAR; PG8_SCHED;
            PG8_LDB(B1, 1, 1); PG8_STAGE(PG8_SB(1, 0), b3, voffB);
            PG8_BAR; PG8_WAIT_L(0); PG8_MMA(0, 1, At, B1); PG8_BAR;
            PG8_LDA(At, 1, 1); PG8_STAGE(PG8_SA(1, 0), a3, voffA);
            PG8_BAR; PG8_WAIT_L(0); PG8_MMA(1, 0, At, B0); PG8_BAR; PG8_SCHED;
            PG8_STAGE(PG8_SB(1, 1), b3 + hstep, voffB);
            PG8_WAIT_V(6); PG8_BAR; PG8_MMA(1, 1, At, B1); PG8_BAR;
            }
        }
        if constexpr (ALIGN_EPI) { if (wr == 0) PG8_BAR; }
        if constexpr (!Epi::AFTER_DRAIN) { E(acc, cur, wr, wc, fr, fq); S.done(cur); }
        if (!has_next) break;
#pragma unroll
        for (int a = 0; a < 2; ++a)
#pragma unroll
            for (int b = 0; b < 2; ++b)
#pragma unroll
                for (int m = 0; m < 4; ++m)
#pragma unroll
                    for (int n = 0; n < 2; ++n) acc[a][b][m][n] = (f32x4){0.f, 0.f, 0.f, 0.f};
        cur = nxt; cA = nA; cB = nB; ++ui;
        if constexpr (ALIGN_EPI) { if (wr == 1) PG8_BAR; }
    }
    PG8_WAIT_V(0);
    if constexpr (!ALIGN_EPI) { if (wr == 0) PG8_BAR; }
    PG8_BAR;
    if constexpr (Epi::AFTER_DRAIN) { E.fused(acc, cur, wr, wc, fr, fq, lds, wid, lane); S.done(cur); }
#undef PG8_SA
#undef PG8_SB
#undef PG8_STAGE
#undef PG8_LDA
#undef PG8_LDB
#undef PG8_MMA
#undef PG8_WAIT_V
#undef PG8_WAIT_L
#undef PG8_BAR
#undef PG8_SCHED
}
}

namespace xb {
#define XLAS __attribute__((address_space(3)))
__device__ __forceinline__ unsigned long long rt() { return __builtin_amdgcn_s_memrealtime(); }
#define XB_TMO      128
#define XB_XCNT(j)  (256  + 64 * (j))
#define XB_XSUB(j)  (1280 + 64 * (j))
#define XB_XGEN(j)  (2304 + 64 * (j))
#define XB_TOP      3328
#define XB_TOPGEN   3392
#define XCD_BAR_WORDS 3456
#define XB_SPIN_CAP (1u << 18)

__device__ __forceinline__ unsigned xb_ld(unsigned* p)              { return __hip_atomic_load(p, __ATOMIC_RELAXED, __HIP_MEMORY_SCOPE_AGENT); }
__device__ __forceinline__ unsigned xb_add(unsigned* p, unsigned v) { return __hip_atomic_fetch_add(p, v, __ATOMIC_RELAXED, __HIP_MEMORY_SCOPE_AGENT); }
__device__ __forceinline__ unsigned xb_xcc_id() { return (unsigned)__builtin_amdgcn_s_getreg((3 << 11) | 20) & 0xFu; }
#define XB_SPIN(cond, bar) do { unsigned _sp = 0; while (cond) { __builtin_amdgcn_s_sleep(1); \
    if ((++_sp & 255u) == 0u) { if (xb_ld(&(bar)[XB_TMO])) break; if (_sp > XB_SPIN_CAP) { atomicAdd(&(bar)[XB_TMO], 1u); break; } } } } while (0)

struct XcdBarrier {
    unsigned* bar; unsigned x;
    volatile XLAS unsigned* st;
};

__device__ __forceinline__ XcdBarrier xcd_barrier_post(unsigned* bar, volatile XLAS unsigned* st) {
    XcdBarrier b; b.bar = bar; b.x = xb_xcc_id(); b.st = st;
    if (threadIdx.x == 0) (void)xb_add(&bar[XB_XCNT(b.x)], 1u);
    return b;
}
__device__ __forceinline__ void xcd_barrier_complete(unsigned* bar, unsigned x, unsigned& nloc, unsigned& nx) {
    const unsigned G = gridDim.x * gridDim.y * gridDim.z;
    unsigned sum, cnt, mine, sp = 0u;
    for (;;) {
        sum = 0u; cnt = 0u; mine = 0u;
#pragma unroll
        for (unsigned j = 0; j < 16; ++j) { const unsigned c = xb_ld(&bar[XB_XCNT(j)]); sum += c; cnt += (c > 0u) ? 1u : 0u; mine = (j == x) ? c : mine; }
        if (sum == G) break;
        __builtin_amdgcn_s_sleep(1);
        if ((++sp & 255u) == 0u) { if (xb_ld(&bar[XB_TMO])) break; if (sp > XB_SPIN_CAP) { atomicAdd(&bar[XB_TMO], 1u); break; } }
    }
    nloc = mine > 0u ? mine : 1u; nx = cnt > 0u ? cnt : 1u;
}

__device__ __forceinline__ void xcd_barrier(const XcdBarrier& b, int wv) {
    int lane_; asm volatile("v_mbcnt_lo_u32_b32 %0, -1, 0\n\tv_mbcnt_hi_u32_b32 %0, -1, %0" : "=v"(lane_)); asm volatile("" : "+s"(wv)); const bool leader_thread = ((wv << 6) | lane_) == 0;
    asm volatile("s_waitcnt vmcnt(0)" ::: "memory");
    __syncthreads();
    if (leader_thread) {
        unsigned* bar = b.bar; asm volatile("" : "+s"(bar));
        __builtin_amdgcn_s_waitcnt(0);
        unsigned nloc = b.st[0], nx = b.st[1];
        if (nloc == 0u) { xcd_barrier_complete(bar, b.x, nloc, nx); b.st[0] = nloc; b.st[1] = nx; }
        const unsigned old = xb_add(&bar[XB_XSUB(b.x)], 1u);
        const unsigned gen = old / nloc;
        if (old + 1u == (gen + 1u) * nloc) {
            __builtin_amdgcn_fence(__ATOMIC_RELEASE, "agent");
            asm volatile("s_waitcnt vmcnt(0)" ::: "memory");
            const unsigned og = xb_add(&bar[XB_TOP], 1u);
            const unsigned tg = og / nx;
            if (og + 1u == (tg + 1u) * nx) xb_add(&bar[XB_TOPGEN], 1u);
            else XB_SPIN(xb_ld(&bar[XB_TOPGEN]) == tg, bar);
            __builtin_amdgcn_fence(__ATOMIC_ACQUIRE, "agent");
            xb_add(&bar[XB_XGEN(b.x)], 1u);
            asm volatile("s_waitcnt vmcnt(0)" ::: "memory");
        } else {
            XB_SPIN(xb_ld(&bar[XB_XGEN(b.x)]) == gen, bar);
            __builtin_amdgcn_fence(__ATOMIC_ACQUIRE, "agent");
            asm volatile("s_waitcnt vmcnt(0)" ::: "memory");
        }
    }
    __syncthreads();
}

}

#ifndef FX_PROBE
#define FX_PROBE 0
#endif
namespace fx {
#define LAS __attribute__((address_space(3)))
typedef unsigned short bf16_t;
typedef short bf16x8 __attribute__((ext_vector_type(8)));
typedef float f32x4 __attribute__((ext_vector_type(4)));
typedef float f32x2 __attribute__((ext_vector_type(2)));
typedef float f32x16 __attribute__((ext_vector_type(16)));
typedef unsigned u32x4 __attribute__((ext_vector_type(4)));
typedef unsigned u32x2 __attribute__((ext_vector_type(2)));
typedef __bf16 bf16x2_t __attribute__((ext_vector_type(2)));
typedef LAS unsigned char lds_u8;

constexpr int NWAVES = 8, NTHREADS = 512;
constexpr int PROJ_PITCH = 2560;
#define PIMG_OFF(grp32, chunk, r32) ((((size_t)(grp32) * 320 + (chunk)) * 32 + (r32)) * 16)
constexpr float LOG2E = 1.4426950408889634f;
constexpr size_t MiB = (size_t)1 << 20;
constexpr size_t WS_CTL = 0, CTL_ZERO_BYTES = 256 * 1024;
constexpr size_t WS_WTIN = 1 * MiB;
constexpr size_t WS_WTUQ = 13 * MiB;
constexpr size_t WS_WTUKV = 14 * MiB;
constexpr size_t WS_WTOUT = 15 * MiB;
constexpr size_t WS_ROPE = 19 * MiB;
#define ROPE_OFF(grp32, chunk, r32) ((((size_t)(grp32) * 8 + (chunk)) * 32 + (r32)) * 16)
constexpr size_t WS_Y = 21 * MiB;
constexpr size_t WS_PROJ = 54 * MiB;
constexpr size_t WS_MEMKV = 134 * MiB;
constexpr size_t WS_VMLA = 183 * MiB;
constexpr size_t OUT_QMLA = 0, OUT_KMLA = 24 * MiB;
constexpr size_t WS_QDIF = 199 * MiB, WS_KDIF = 207 * MiB, WS_VDIF = 215 * MiB;
constexpr size_t WS_QMEM = 223 * MiB, WS_KMEM = 231 * MiB, WS_VMEM = 231 * MiB + 512 * 1024;
constexpr size_t WS_XB = 135 * MiB;
constexpr size_t WS_ROWSS = 232 * MiB;
constexpr size_t WS_END = 234 * MiB;
constexpr int CTL_SC = 4096, CTL_Q = 8192, CTL_BAR = 16384;
enum { SC_LAM = 0, SC_OSCALE = 1 };

struct Params {
    const float *x, *mem; const int* pos;
    const float *norm_g, *w_in, *q_norm_g, *kv_norm_g, *w_uq, *w_ukv, *qn_g, *kn_g, *dqn_g, *dkn_g, *dlam, *subln_g, *mem_norm_g, *w_mem_kv, *mqn_g, *mkn_g, *w_out;
    float* out; unsigned char* ws;
    int ph_lo, ph_hi;
};

typedef const __attribute__((address_space(4))) Params& KP;
__device__ __forceinline__ const __attribute__((address_space(4))) Params* launder_kp() {
    const __attribute__((address_space(4))) Params* pk = (const __attribute__((address_space(4))) Params*)__builtin_amdgcn_kernarg_segment_ptr();
    asm volatile("" : "+s"(pk)); return pk; }
__device__ __forceinline__ int opaque_bid() { int b = blockIdx.x; asm volatile("" : "+s"(b)); return b; }
__device__ __forceinline__ int opaque_grid() { int g = gridDim.x; asm volatile("" : "+s"(g)); return g; }
__device__ __forceinline__ float bflo(unsigned w) { return __uint_as_float(w << 16); }
__device__ __forceinline__ float bfhi(unsigned w) { return __uint_as_float(w & 0xffff0000u); }
__device__ __forceinline__ unsigned pk2(float lo, float hi) { f32x2 v = {lo, hi}; bf16x2_t b = __builtin_convertvector(v, bf16x2_t); return __builtin_bit_cast(unsigned, b); }
__device__ __forceinline__ int crow(int r, int hi) { return (r & 3) + 8 * (r >> 2) + 4 * hi; }
__device__ __forceinline__ float xchg32(float v) { const auto rr = __builtin_amdgcn_permlane32_swap(__float_as_uint(v), __float_as_uint(v), false, false); return __uint_as_float(rr[0] == __float_as_uint(v) ? rr[1] : rr[0]); }
#ifndef FX_P0_NT
#define FX_P0_NT 1
#endif
template <int XM> __device__ __forceinline__ float swz_xor(float v) { return __uint_as_float((unsigned)__builtin_amdgcn_ds_swizzle((int)__float_as_uint(v), 0x1f | (XM << 10))); }
__device__ __forceinline__ float xsum32(float v) { const auto rr = __builtin_amdgcn_permlane32_swap(__float_as_uint(v), __float_as_uint(v), false, false); return __uint_as_float(rr[0]) + __uint_as_float(rr[1]); }
__device__ __forceinline__ float xsum16_32(float v) { v += swz_xor<16>(v); return xsum32(v); }
__device__ __forceinline__ int opaque_tid(int wv) { int lane_; asm volatile("v_mbcnt_lo_u32_b32 %0, -1, 0\n\tv_mbcnt_hi_u32_b32 %0, -1, %0" : "=v"(lane_)); asm volatile("" : "+s"(wv)); return (wv << 6) | lane_; }
__device__ __forceinline__ unsigned char* opaque_ptr(unsigned char* p) { asm volatile("" : "+s"(p)); return p; }
#define GAS __attribute__((address_space(1)))
#define LDG16(p) (*(const GAS bf16x8*)(p))
#define MFMA32(a, b, c) __builtin_amdgcn_mfma_f32_32x32x16_bf16((a), (b), (c), 0, 0, 0)

__device__ __forceinline__ void load_tile16(const bf16_t* p, int hi, f32x16& v) {
#pragma unroll
    for (int g = 0; g < 4; ++g) { const u32x2 w = *(const GAS u32x2*)(p + 8 * g + 4 * hi); v[4 * g] = bflo(w.x); v[4 * g + 1] = bfhi(w.x); v[4 * g + 2] = bflo(w.y); v[4 * g + 3] = bfhi(w.y); }
}
__device__ __forceinline__ void load_gain16(const float* p, int hi, f32x16& v) {
#pragma unroll
    for (int g = 0; g < 4; ++g) { const f32x4 w = *(const GAS f32x4*)(p + 8 * g + 4 * hi); v[4 * g] = w.x; v[4 * g + 1] = w.y; v[4 * g + 2] = w.z; v[4 * g + 3] = w.w; }
}
__device__ __forceinline__ float sumsq16(const f32x16& v) { float s = 0.f;
#pragma unroll
    for (int r = 0; r < 16; ++r) s += v[r] * v[r];
    return s; }
__device__ __forceinline__ u32x4 pack8(const f32x16& v, int s) { u32x4 o; o.x = pk2(v[8 * s], v[8 * s + 1]); o.y = pk2(v[8 * s + 2], v[8 * s + 3]); o.z = pk2(v[8 * s + 4], v[8 * s + 5]); o.w = pk2(v[8 * s + 6], v[8 * s + 7]); return o; }
__device__ __forceinline__ void rope16(f32x16& v, const f32x2* cs, int hi) {
#pragma unroll
    for (int g = 0; g < 2; ++g) {
        const f32x4 a = *(const GAS f32x4*)(cs + 8 * g + 4 * hi), b = *(const GAS f32x4*)(cs + 8 * g + 4 * hi + 2);
        const float c[4] = {a.x, a.z, b.x, b.z}, s[4] = {a.y, a.w, b.y, b.w};
#pragma unroll
        for (int e = 0; e < 4; ++e) { const int r = 4 * g + e; const float x1 = v[r], x2 = v[r + 8]; v[r] = x1 * c[e] - x2 * s[e]; v[r + 8] = x2 * c[e] + x1 * s[e]; }
    }
}

__device__ __forceinline__ void glds16(const void* gsrc, unsigned lds_dst) {
    unsigned keep;
    asm volatile("s_mov_b32 %0, m0\n\ts_mov_b32 m0, %2\n\ts_nop 0\n\tglobal_load_lds_dwordx4 %1, off\n\ts_mov_b32 m0, %0" : "=&s"(keep) : "v"(gsrc), "s"(lds_dst) : "memory");
}

__device__ __forceinline__ void glds16_off(const unsigned char* sbase, unsigned voff, unsigned lds_dst) {
    unsigned keep;
    asm volatile("s_mov_b32 %0, m0\n\ts_mov_b32 m0, %3\n\ts_nop 0\n\tglobal_load_lds_dwordx4 %1, %2\n\ts_mov_b32 m0, %0" : "=&s"(keep) : "v"(voff), "s"(sbase), "s"(lds_dst) : "memory");
}
__device__ __forceinline__ void p0_transpose_item(const float* W, int K, int N, bf16_t* WT, int row_off, const float* gain, LAS float* scr, int item, int lane, int img_nks) {
    const int nblk = N / 32, kb = item / nblk, nb = item % nblk, k0 = 64 * kb, n0 = 32 * nb;
    const int c = lane & 7;
    f32x4 g0 = {1.f, 1.f, 1.f, 1.f}, g1 = g0;
    if (gain) { g0 = *(const GAS f32x4*)(gain + k0 + 8 * c); g1 = *(const GAS f32x4*)(gain + k0 + 8 * c + 4); }
    float w[32];
#pragma unroll
    for (int i = 0; i < 32; ++i) w[i] = FX_P0_NT ? __builtin_nontemporal_load((const GAS float*)(W + (size_t)(k0 + 2 * i + (lane >> 5)) * N + n0 + (lane & 31))) : *(const GAS float*)(W + (size_t)(k0 + 2 * i + (lane >> 5)) * N + n0 + (lane & 31));
#pragma unroll
    for (int i = 0; i < 32; ++i) scr[(2 * i + (lane >> 5)) * 33 + (lane & 31)] = w[i];
    asm volatile("s_waitcnt lgkmcnt(0)" ::: "memory");
#pragma unroll
    for (int j = 0; j < 4; ++j) { const int n = (lane >> 3) + 8 * j; const LAS float* s = scr + (8 * c) * 33 + n;
        u32x4 o; o.x = pk2(s[0 * 33] * g0[0], s[1 * 33] * g0[1]); o.y = pk2(s[2 * 33] * g0[2], s[3 * 33] * g0[3]); o.z = pk2(s[4 * 33] * g1[0], s[5 * 33] * g1[1]); o.w = pk2(s[6 * 33] * g1[2], s[7 * 33] * g1[3]);
        if (img_nks) *(GAS u32x4*)(WT + ((size_t)(((row_off + n0) / 32) * img_nks + (k0 / 16 + (c >> 1))) * 64 + (c & 1) * 32 + n) * 8) = o;
        else *(GAS u32x4*)(WT + (size_t)(row_off + n0 + n) * K + k0 + 8 * c) = o; }
    asm volatile("s_waitcnt lgkmcnt(0)" ::: "memory");
}
__device__ __forceinline__ float wave_sum(float v) {
    v += swz_xor<1>(v); v += swz_xor<2>(v); v += swz_xor<4>(v); v += swz_xor<8>(v); v += swz_xor<16>(v);
    return xsum32(v);
}
__device__ __forceinline__ void row_to_bf16_ss(const float* xrow, bf16_t* orow, float* ssrow, int lane) {
    const GAS f32x4* xr = (const GAS f32x4*)xrow + lane;
    f32x4 v[4]; float s = 0.f;
#pragma unroll
    for (int j = 0; j < 4; ++j) { v[j] = FX_P0_NT ? __builtin_nontemporal_load(xr + 64 * j) : xr[64 * j]; s += (v[j].x * v[j].x + v[j].y * v[j].y) + (v[j].z * v[j].z + v[j].w * v[j].w); }
    s = wave_sum(s);
    GAS u32x2* o8 = (GAS u32x2*)orow + lane;
#pragma unroll
    for (int j = 0; j < 4; ++j) { u32x2 w; w.x = pk2(v[j].x, v[j].y); w.y = pk2(v[j].z, v[j].w); o8[64 * j] = w; }
    if (lane < 16) ssrow[lane] = lane == 0 ? s : 0.f;
}
__device__ __forceinline__ void xb_rows(const float* x, bf16_t* XB, float* SS, int nrows, int gw, int NGW, int lane) {
    int m = gw;
    for (; m + NGW < nrows; m += 2 * NGW) {
        const GAS f32x4* xa = (const GAS f32x4*)(x + (size_t)m * 1024) + lane; const GAS f32x4* xb2 = (const GAS f32x4*)(x + (size_t)(m + NGW) * 1024) + lane;
        f32x4 va[4], vb[4]; float sa = 0.f, sb = 0.f;
#pragma unroll
        for (int j = 0; j < 4; ++j) { if (FX_P0_NT) { va[j] = __builtin_nontemporal_load(xa + 64 * j); vb[j] = __builtin_nontemporal_load(xb2 + 64 * j); } else { va[j] = xa[64 * j]; vb[j] = xb2[64 * j]; } }
#pragma unroll
        for (int j = 0; j < 4; ++j) { sa += (va[j].x * va[j].x + va[j].y * va[j].y) + (va[j].z * va[j].z + va[j].w * va[j].w); sb += (vb[j].x * vb[j].x + vb[j].y * vb[j].y) + (vb[j].z * vb[j].z + vb[j].w * vb[j].w); }
        sa = wave_sum(sa); sb = wave_sum(sb);
        GAS u32x2* oa = (GAS u32x2*)(XB + (size_t)m * 1024) + lane; GAS u32x2* ob = (GAS u32x2*)(XB + (size_t)(m + NGW) * 1024) + lane;
#pragma unroll
        for (int j = 0; j < 4; ++j) { u32x2 w; w.x = pk2(va[j].x, va[j].y); w.y = pk2(va[j].z, va[j].w); oa[64 * j] = w; w.x = pk2(vb[j].x, vb[j].y); w.y = pk2(vb[j].z, vb[j].w); ob[64 * j] = w; }
        if (lane < 16) { SS[(size_t)m * 16 + lane] = lane == 0 ? sa : 0.f; SS[(size_t)(m + NGW) * 16 + lane] = lane == 0 ? sb : 0.f; }
    }
    for (; m < nrows; m += NGW) row_to_bf16_ss(x + (size_t)m * 1024, XB + (size_t)m * 1024, SS + (size_t)m * 16, lane);
}

constexpr int I_IN = 16 * 77, I_MEM = 16 * 16, I_UQ = 4 * 24, I_UKV = 2 * 32, I_OUT = 16 * 32, I_PAD = 96;
constexpr int PER_L = I_IN + I_MEM + I_UQ + I_UKV + I_OUT + I_PAD;
__device__ __forceinline__ void p0_weight_item(KP P, unsigned char* ws, LAS float* scr, int lane, int l, int r) {
    bf16_t* WTIN = (bf16_t*)(ws + WS_WTIN); bf16_t* WTUQ = (bf16_t*)(ws + WS_WTUQ); bf16_t* WTUKV = (bf16_t*)(ws + WS_WTUKV); bf16_t* WTOUT = (bf16_t*)(ws + WS_WTOUT);
    if (r < I_IN) { p0_transpose_item(P.w_in + (size_t)l * 1024 * D_IN, 1024, D_IN, WTIN, l * 2560, P.norm_g + l * 1024, scr, r, lane, 0); return; } r -= I_IN;
    if (r < I_MEM) { p0_transpose_item(P.w_mem_kv + (size_t)l * 1024 * 512, 1024, 512, WTIN, 5120 + l * 512, P.mem_norm_g + l * 1024, scr, r, lane, 0); return; } r -= I_MEM;
    if (r < I_UQ) { p0_transpose_item(P.w_uq + (size_t)l * 256 * 768, 256, 768, WTUQ, l * 768, P.q_norm_g + l * 256, scr, r, lane, 16); return; } r -= I_UQ;
    if (r < I_UKV) { p0_transpose_item(P.w_ukv + (size_t)l * 128 * 1024, 128, 1024, WTUKV, l * 1024, P.kv_norm_g + l * 128, scr, r, lane, 8); return; } r -= I_UKV;
    if (r < I_OUT) { p0_transpose_item(P.w_out + (size_t)l * 1024 * 1024, 1024, 1024, WTOUT, l * 1024, nullptr, scr, r, lane, 0); return; } r -= I_OUT;
    { u32x4* row = (u32x4*)(WTIN + (size_t)(l * 2560 + D_IN + r) * 1024); const u32x4 z = {0u, 0u, 0u, 0u}; row[lane] = z; row[lane + 64] = z; }
}
constexpr int R_OUT0 = I_IN + I_MEM + I_UQ + I_UKV;
constexpr int N_DEFER = PER_L - I_MEM + I_OUT;
__device__ __forceinline__ void p0_weights_deferred(KP P, lds_u8* lds, int wv, int nB) {
    const int tid = opaque_tid(wv), lane = tid & 63, wave = tid >> 6;
    const int bid = opaque_bid(), G = opaque_grid();
    unsigned char* ws = opaque_ptr(P.ws);
    LAS float* scr = (LAS float*)(lds + wave * 16384);
    int first = nB, nprt = G - nB;
    if (nB > 0 && G > nB) { int nheavy = NTOK / 64 - 2 * (G - nB); if (nheavy < 0) nheavy = 0; if (nheavy < G - nB) { first = nB + nheavy; nprt = G - first; } }
    else { first = 0; nprt = G; }
    if (bid < first) return;
    for (int j = (bid - first) * NWAVES + wave; j < N_DEFER; j += nprt * NWAVES) { if (j < I_OUT) p0_weight_item(P, ws, scr, lane, 0, R_OUT0 + j); else { const int j1 = j - I_OUT; p0_weight_item(P, ws, scr, lane, 1, j1 < I_IN ? j1 : j1 + I_MEM); } }
}
__device__ __forceinline__ void p0_prologue(KP P, lds_u8* lds, int wv) {
    const int tid = opaque_tid(wv), lane = tid & 63, wave = tid >> 6;
    const int bid = opaque_bid(), G = opaque_grid();
    const int gw = bid * NWAVES + wave, NGW = G * NWAVES;
    unsigned char* ws = opaque_ptr(P.ws);
    LAS float* scr = (LAS float*)(lds + wave * 16384);
    for (int j = gw; j < PER_L - I_OUT + I_MEM; j += NGW) { if (j < PER_L - I_OUT) p0_weight_item(P, ws, scr, lane, 0, j < R_OUT0 ? j : j + I_OUT); else p0_weight_item(P, ws, scr, lane, 1, I_IN + (j - (PER_L - I_OUT))); }
    bf16_t* XB = (bf16_t*)(ws + WS_XB); float* SS = (float*)(ws + WS_ROWSS);
    xb_rows(P.x, XB, SS, NTOK, gw, NGW, lane);
    xb_rows(P.mem, XB + (size_t)NTOK * 1024, SS + (size_t)NTOK * 16, BATCH * MEM_TOKENS, gw, NGW, lane);
    {
        f32x2* rope = (f32x2*)(ws + WS_ROPE);
        const float invt[16] = {1.0f, 0.5623413324356079f, 0.3162277638912201f, 0.17782793939113617f, 0.10000000149011612f, 0.05623413249850273f, 0.03162277489900589f, 0.017782794311642647f, 0.009999999776482582f, 0.005623413249850273f, 0.003162277629598975f, 0.0017782794311642647f, 0.0010000000474974513f, 0.000562341301701963f, 0.0003162277571391314f, 0.00017782794020604342f};
        for (int e = bid * NTHREADS + tid; e < NTOK * 16; e += G * NTHREADS) {
            const int t = e >> 4, i = e & 15;
            float inv = invt[0];
#pragma unroll
            for (int k = 1; k < 16; ++k) inv = (i == k) ? invt[k] : inv;
            const float ang = (float)P.pos[t] * inv;
            double r = (double)ang * 0.15915494309189535; r -= rint(r);
            f32x2 cs; cs.x = __builtin_amdgcn_cosf((float)r); cs.y = __builtin_amdgcn_sinf((float)r); *(f32x2*)((unsigned char*)rope + ROPE_OFF(t >> 5, i >> 1, t & 31) + 8 * (i & 1)) = cs;
        }
    }
    if (bid == G - 1 && wave == 0) {
        float* SC = (float*)(ws + WS_CTL + CTL_SC);
        for (int l = 0; l < DEPTH; ++l) {
            const float lam_init = 0.8f - 0.6f * expf(-0.3f * (float)l);
            const float* lv = P.dlam + l * 128; const int i = lane & 31;
            float d0 = lane < 32 ? lv[i] * lv[32 + i] : 0.f, d1 = lane < 32 ? lv[64 + i] * lv[96 + i] : 0.f;
            d0 = wave_sum(d0); d1 = wave_sum(d1);
            if (lane == 0) { SC[l * 16 + SC_LAM] = expf(d0) - expf(d1) + lam_init; SC[l * 16 + SC_OSCALE] = 1.0f - lam_init; }
        }
    }
}

#ifndef FX_NT_IMG
#define FX_NT_IMG 0
#endif
#if FX_NT_IMG
#define IMG_STORE(p, v) __builtin_nontemporal_store((v), (GAS u32x4*)(p))
#else
#define IMG_STORE(p, v) (*(GAS u32x4*)(p) = (v))
#endif
__device__ __forceinline__ void store_q_tile(unsigned char* qimg, int nch, int qg, int ft, const f32x16& v, int r32, int hi) {
#pragma unroll
    for (int s = 0; s < 2; ++s) IMG_STORE((u32x4*)(qimg + ((size_t)qg * nch + 2 * (2 * ft + s) + hi) * 512 + r32 * 16), pack8(v, s));
}
__device__ __forceinline__ void store_k_tile(unsigned char* kimg, int nch, int tile, int row64, int ft, const f32x16& v, int hi) {
#pragma unroll
    for (int s = 0; s < 2; ++s) IMG_STORE((u32x4*)(kimg + ((size_t)tile * nch + 2 * (2 * ft + s) + hi) * 1024 + row64 * 16), pack8(v, s));
}
__device__ __forceinline__ void store_v_tile(unsigned char* vimg, int tile, int tg, int dt, const f32x16& v, int r32, int hi) {
#pragma unroll
    for (int s = 0; s < 2; ++s) IMG_STORE((u32x4*)(vimg + ((size_t)tile * 8 + 2 * (2 * tg + s) + hi) * 1024 + (32 * dt + r32) * 16), pack8(v, s));
}
__device__ __forceinline__ void transpose_v64(const bf16_t* src_row  , unsigned char* vimg, int tile, int tg, int r32, int hi) {
    bf16x8 xf[4];
#pragma unroll
    for (int ks = 0; ks < 4; ++ks) xf[ks] = LDG16(src_row + 16 * ks + 8 * hi);
#pragma unroll
    for (int dt = 0; dt < 2; ++dt) {
        f32x16 acc = {};
#pragma unroll
        for (int kk = 0; kk < 2; ++kk) {
            const int ks = 2 * dt + kk;
            bf16x8 id;
#pragma unroll
            for (int j = 0; j < 8; ++j) id[j] = (16 * kk + 8 * hi + j == r32) ? (short)0x3f80 : (short)0;
            acc = MFMA32(xf[ks], id, acc);
        }
        store_v_tile(vimg, tile, tg, dt, acc, r32, hi);
    }
}

__device__ __forceinline__ void p2_mla(KP P, int l, lds_u8* lds, int wv) {
    const int tid = opaque_tid(wv), lane = tid & 63, wave = __builtin_amdgcn_readfirstlane(tid >> 6), r32 = lane & 31, hi = lane >> 5;
    unsigned char* ws = opaque_ptr(P.ws);
    const bf16_t* PROJ = (const bf16_t*)(ws + WS_PROJ);
    const unsigned char* pimg = ws + WS_PROJ;
    const int bid = opaque_bid(), G = opaque_grid();
#if FX_PROBE >= 10
    volatile LAS unsigned* prb = (volatile LAS unsigned*)(lds + 135168 + 64); const bool pon = (bid == 0 && wave == 0 && l == 0);
#define P2S(i) do { if (pon) { const unsigned long long t_ = __builtin_amdgcn_s_memtime(); if (lane == 0) { prb[8 + (i)] += (unsigned)(t_ - pstamp); } pstamp = t_; } } while (0)
    unsigned long long pstamp = __builtin_amdgcn_s_memtime();
#else
#define P2S(i)
#endif
    for (int unit = bid; unit < 256; unit += G) {
        const int h = (unit >> 3) & 7, tb = (unit & 7) * 4 + (unit >> 6);
        {
            const unsigned char* wq = ws + WS_WTUQ + (size_t)l * (768 * 256 * 2) + (size_t)h * 49152;
            const unsigned char* wkv = ws + WS_WTUKV + (size_t)l * (1024 * 128 * 2) + (size_t)h * 32768;
            const unsigned lds0 = (unsigned)(uintptr_t)lds;
#pragma unroll 1
            for (int p = wave; p < 80; p += 8) {
                const unsigned char* src = p < 48 ? wq + p * 1024 : wkv + (p - 48) * 1024;
                glds16(src + lane * 16, (unsigned)__builtin_amdgcn_readfirstlane(lds0 + p * 1024));
            }
            if (tid < 192) ((LAS float*)(lds + 81920))[tid] = tid < 96 ? P.qn_g[l * 96 + tid] : P.kn_g[l * 96 + tid - 96];
        }
        P2S(0);
        const lds_u8* wql = lds + lane * 16;
        const lds_u8* wkl = lds + 49152 + lane * 16;
        const LAS float* gl = (const LAS float*)(lds + 81920);
#pragma unroll 1
        for (int g = wave; g < 16; g += 8) {
            const int Gi = tb * 16 + g, b = Gi >> 8, qg = Gi & 255, tile = qg >> 1, tg = qg & 1;
            const int T = Gi * 32 + r32;
            const int row64 = 32 * tg + r32, bh = b * 8 + h;
            const bf16_t* prow = PROJ + (size_t)T * PROJ_PITCH;
            const unsigned char* cs = ws + WS_ROPE + ROPE_OFF(T >> 5, 2 * hi, r32);
            bf16x8 xq[16], xkv[8]; u32x2 krw[4]; f32x4 csv[4];
#pragma unroll
            for (int ks = 0; ks < 16; ++ks) xq[ks] = LDG16(pimg + PIMG_OFF(Gi, OFF_CQ / 8 + 2 * ks + hi, r32));
#pragma unroll
            for (int ks = 0; ks < 8; ++ks) xkv[ks] = LDG16(pimg + PIMG_OFF(Gi, OFF_CKV / 8 + 2 * ks + hi, r32));
#pragma unroll
            for (int q4 = 0; q4 < 4; ++q4) krw[q4] = *(const GAS u32x2*)(pimg + PIMG_OFF(Gi, OFF_KR / 8 + q4, r32) + 8 * hi);
#pragma unroll
            for (int q4 = 0; q4 < 2; ++q4) { csv[2 * q4] = *(const GAS f32x4*)(cs + (4 * q4) * 512); csv[2 * q4 + 1] = *(const GAS f32x4*)(cs + (4 * q4 + 1) * 512); }
            __builtin_amdgcn_sched_barrier(0);
            if (g == wave) asm volatile("s_waitcnt vmcnt(0) lgkmcnt(0)\n\ts_barrier" ::: "memory");
            __builtin_amdgcn_sched_barrier(0);
#define P2_ROPE(v) do { _Pragma("unroll") for (int g2 = 0; g2 < 2; ++g2) { const f32x4 a_ = csv[2 * g2], b_ = csv[2 * g2 + 1]; const float c_[4] = {a_.x, a_.z, b_.x, b_.z}, s_[4] = {a_.y, a_.w, b_.y, b_.w}; \
        _Pragma("unroll") for (int e = 0; e < 4; ++e) { const int r = 4 * g2 + e; const float x1 = v[r], x2 = v[r + 8]; v[r] = x1 * c_[e] - x2 * s_[e]; v[r + 8] = x2 * c_[e] + x1 * s_[e]; } } } while (0)
#define P2_GAIN(dst, off) do { _Pragma("unroll") for (int g2 = 0; g2 < 4; ++g2) { const f32x4 w_ = *(const LAS f32x4*)(gl + (off) + 8 * g2 + 4 * hi); dst[4 * g2] = w_.x; dst[4 * g2 + 1] = w_.y; dst[4 * g2 + 2] = w_.z; dst[4 * g2 + 3] = w_.w; } } while (0)
            P2S(1);
            {
                float ssq = 0.f;
#pragma unroll
                for (int ks = 0; ks < 16; ++ks)
#pragma unroll
                    for (int j = 0; j < 8; ++j) { const float f = __uint_as_float((unsigned)(unsigned short)xq[ks][j] << 16); ssq += f * f; }
                const float rstd_q = __builtin_amdgcn_rsqf(xsum32(ssq) * (1.f / 256.f) + RMS_EPS);
                f32x16 qa[3]; qa[0] = f32x16{}; qa[1] = f32x16{}; qa[2] = f32x16{};
                {
                    bf16x8 fr[4];
#pragma unroll
                    for (int i = 0; i < 4; ++i) fr[i] = *(const LAS bf16x8*)(wql + i * 1024);
                    __builtin_amdgcn_sched_barrier(0);
#pragma unroll
                    for (int i = 0; i < 48; ++i) { qa[i >> 4] = MFMA32(fr[i & 3], xq[i & 15], qa[i >> 4]); if (i + 4 < 48) fr[i & 3] = *(const LAS bf16x8*)(wql + (i + 4) * 1024); __builtin_amdgcn_sched_barrier(0); }
                }
                P2S(2);
                float ss = sumsq16(qa[0]) + sumsq16(qa[1]) + sumsq16(qa[2]);
                ss = xsum32(ss) * rstd_q * rstd_q;
                const float rn = rstd_q * (LOG2E / sqrtf(96.f)) * __builtin_amdgcn_rsqf(ss * (1.f / 96.f) + RMS_EPS);
                unsigned char* qimg = opaque_ptr((unsigned char*)P.out) + OUT_QMLA + (size_t)bh * (256 * 12 * 512);
#pragma unroll
                for (int ft = 0; ft < 3; ++ft) { f32x16 gn; P2_GAIN(gn, 32 * ft);
#pragma unroll
                    for (int r = 0; r < 16; ++r) qa[ft][r] *= rn * gn[r];
                    if (ft == 2) P2_ROPE(qa[2]);
                    store_q_tile(qimg, 12, qg, ft, qa[ft], r32, hi); }
            }
            __builtin_amdgcn_sched_barrier(0);
            P2S(3);
            {
                float sskv = 0.f;
#pragma unroll
                for (int ks = 0; ks < 8; ++ks)
#pragma unroll
                    for (int j = 0; j < 8; ++j) { const float f = __uint_as_float((unsigned)(unsigned short)xkv[ks][j] << 16); sskv += f * f; }
                const float rstd_kv = __builtin_amdgcn_rsqf(xsum32(sskv) * (1.f / 128.f) + RMS_EPS);
                f32x16 ka[2], va[2]; ka[0] = f32x16{}; ka[1] = f32x16{}; va[0] = f32x16{}; va[1] = f32x16{};
                {
                    bf16x8 fr[4];
#pragma unroll
                    for (int i = 0; i < 4; ++i) fr[i] = *(const LAS bf16x8*)(wkl + i * 1024);
                    __builtin_amdgcn_sched_barrier(0);
#pragma unroll
                    for (int i = 0; i < 32; ++i) {
                        if (i < 16) ka[i >> 3] = MFMA32(fr[i & 3], xkv[i & 7], ka[i >> 3]); else va[(i >> 3) - 2] = MFMA32(xkv[i & 7], fr[i & 3], va[(i >> 3) - 2]);
                        if (i + 4 < 32) fr[i & 3] = *(const LAS bf16x8*)(wkl + (i + 4) * 1024);
                        __builtin_amdgcn_sched_barrier(0); }
                }
                P2S(5);
                f32x16 kr;
#pragma unroll
                for (int q4 = 0; q4 < 4; ++q4) { kr[4 * q4] = bflo(krw[q4].x); kr[4 * q4 + 1] = bfhi(krw[q4].x); kr[4 * q4 + 2] = bflo(krw[q4].y); kr[4 * q4 + 3] = bfhi(krw[q4].y); }
                const float ss = xsum32(sumsq16(ka[0]) + sumsq16(ka[1])) * rstd_kv * rstd_kv + xsum32(sumsq16(kr));
                const float rk = __builtin_amdgcn_rsqf(ss * (1.f / 96.f) + RMS_EPS);
                unsigned char* kimg = opaque_ptr((unsigned char*)P.out) + OUT_KMLA + (size_t)bh * (128 * 12 * 1024);
#pragma unroll
                for (int ft = 0; ft < 2; ++ft) { f32x16 gn; P2_GAIN(gn, 96 + 32 * ft);
#pragma unroll
                    for (int r = 0; r < 16; ++r) ka[ft][r] *= rstd_kv * rk * gn[r];
                    store_k_tile(kimg, 12, tile, row64, ft, ka[ft], hi); }
                f32x16 gn; P2_GAIN(gn, 96 + 64);
#pragma unroll
                for (int r = 0; r < 16; ++r) kr[r] *= rk * gn[r];
                P2_ROPE(kr);
                store_k_tile(kimg, 12, tile, row64, 2, kr, hi);
                P2S(6);
                unsigned char* vimg = ws + WS_VMLA + (size_t)bh * (128 * 8 * 1024);
#pragma unroll
                for (int dt = 0; dt < 2; ++dt) {
#pragma unroll
                    for (int r = 0; r < 16; ++r) va[dt][r] *= __uint_as_float((unsigned)__builtin_amdgcn_ds_bpermute(crow(r, hi) << 2, (int)__float_as_uint(rstd_kv)));
                    store_v_tile(vimg, tile, tg, dt, va[dt], r32, hi); }
            }
            __builtin_amdgcn_sched_barrier(0);
            P2S(4);
#undef P2_ROPE
#undef P2_GAIN
        }
        asm volatile("s_waitcnt lgkmcnt(0)\n\ts_barrier" ::: "memory");
    }
}

template <int VAR>
__device__ __forceinline__ void p2_tokens(KP P, int l, int wv, int nB  ) {
    const int tid = opaque_tid(wv), lane = tid & 63, wave = __builtin_amdgcn_readfirstlane(tid >> 6), r32 = lane & 31, hi = lane >> 5;
    unsigned char* ws = opaque_ptr(P.ws);
    const bf16_t* PROJ = (const bf16_t*)(ws + WS_PROJ);
    const float* SC = (const float*)(ws + WS_CTL + CTL_SC) + l * 16; (void)SC;
    const int tg = wave & 1, hq = wave >> 1;
    const int bid = opaque_bid(), G = opaque_grid();
    int blk0 = bid, bstride = G;
    if (nB > 0 && G > nB) { blk0 = bid - nB; bstride = G - nB; }
    for (int blk = blk0; blk >= 0 && blk < NTOK / 64; blk += bstride) {
        const int b = blk >> 7, tile = blk & 127, qg = tile * 2 + tg;
        const int T = b * SEQ + tile * 64 + 32 * tg + r32;
        const int row64 = 32 * tg + r32;
        const unsigned char* pg = (const unsigned char*)PROJ + PIMG_OFF(T >> 5, 0, r32) + 8 * hi;
        const unsigned char* cs = ws + WS_ROPE + ROPE_OFF(T >> 5, 2 * hi, r32);
        __builtin_amdgcn_sched_barrier(0);
        if (VAR != 3) {
            u32x2 rq[2][4], rk[2][4], rm[2][4]; bf16x8 xv[4]; f32x4 csv[4];
#pragma unroll
            for (int mm = 0; mm < 2; ++mm)
#pragma unroll
                for (int q4 = 0; q4 < 4; ++q4) { rq[mm][q4] = __builtin_nontemporal_load((const GAS u32x2*)(pg + (OFF_DQ / 8 + (2 * hq + mm) * 4 + q4) * 512)); rk[mm][q4] = __builtin_nontemporal_load((const GAS u32x2*)(pg + (OFF_DK / 8 + (2 * hq + mm) * 4 + q4) * 512));
                                                 rm[mm][q4] = __builtin_nontemporal_load((const GAS u32x2*)(pg + (OFF_MQ / 8 + hq * 8 + 4 * mm + q4) * 512)); }
#pragma unroll
            for (int ks = 0; ks < 4; ++ks) xv[ks] = __builtin_nontemporal_load((const GAS bf16x8*)(pg - 8 * hi + (OFF_DV / 8 + hq * 8 + 2 * ks + hi) * 512));
#pragma unroll
            for (int q4 = 0; q4 < 2; ++q4) { csv[2 * q4] = *(const GAS f32x4*)(cs + (4 * q4) * 512); csv[2 * q4 + 1] = *(const GAS f32x4*)(cs + (4 * q4 + 1) * 512); }
            f32x16 gq, gk, gm0, gm1;
            load_gain16(P.dqn_g + l * 32, hi, gq); load_gain16(P.dkn_g + l * 32, hi, gk); load_gain16(P.mqn_g + l * 64, hi, gm0); load_gain16(P.mqn_g + l * 64 + 32, hi, gm1);
            __builtin_amdgcn_sched_barrier(0);
#define P2_UNPK(dst, src) do { _Pragma("unroll") for (int q4 = 0; q4 < 4; ++q4) { dst[4 * q4] = bflo(src[q4].x); dst[4 * q4 + 1] = bfhi(src[q4].x); dst[4 * q4 + 2] = bflo(src[q4].y); dst[4 * q4 + 3] = bfhi(src[q4].y); } } while (0)
#define P2_ROPE(v) do { _Pragma("unroll") for (int g2 = 0; g2 < 2; ++g2) { const f32x4 a_ = csv[2 * g2], b_ = csv[2 * g2 + 1]; const float c_[4] = {a_.x, a_.z, b_.x, b_.z}, s_[4] = {a_.y, a_.w, b_.y, b_.w}; \
        _Pragma("unroll") for (int e = 0; e < 4; ++e) { const int r = 4 * g2 + e; const float x1 = v[r], x2 = v[r + 8]; v[r] = x1 * c_[e] - x2 * s_[e]; v[r + 8] = x2 * c_[e] + x1 * s_[e]; } } } while (0)
            const float dscale = LOG2E / sqrtf(32.f);
#pragma unroll
            for (int mm = 0; mm < 2; ++mm) {
                const int g = 2 * hq + mm;
                f32x16 v;
                P2_UNPK(v, rq[mm]);
                { const float rn = dscale * __builtin_amdgcn_rsqf(xsum32(sumsq16(v)) * (1.f / 32.f) + RMS_EPS);
#pragma unroll
                  for (int r = 0; r < 16; ++r) v[r] *= rn * gq[r]; }
                P2_ROPE(v);
                store_q_tile(ws + WS_QDIF + (size_t)(b * 8 + g) * (256 * 4 * 512), 4, qg, 0, v, r32, hi);
                P2_UNPK(v, rk[mm]);
                { const float rn = __builtin_amdgcn_rsqf(xsum32(sumsq16(v)) * (1.f / 32.f) + RMS_EPS);
#pragma unroll
                  for (int r = 0; r < 16; ++r) v[r] *= rn * gk[r]; }
                P2_ROPE(v);
                store_k_tile(ws + WS_KDIF + (size_t)(b * 8 + g) * (128 * 4 * 1024), 4, tile, row64, 0, v, hi);
            }
            {
                unsigned char* vimg = ws + WS_VDIF + (size_t)(b * 4 + hq) * (128 * 8 * 1024);
#pragma unroll
                for (int dt = 0; dt < 2; ++dt) { f32x16 acc = {};
#pragma unroll
                    for (int kk = 0; kk < 2; ++kk) { bf16x8 id;
#pragma unroll
                        for (int j = 0; j < 8; ++j) id[j] = (16 * kk + 8 * hi + j == r32) ? (short)0x3f80 : (short)0;
                        acc = MFMA32(xv[2 * dt + kk], id, acc); }
                    store_v_tile(vimg, tile, tg, dt, acc, r32, hi); }
            }
            {
                f32x16 v0, v1; P2_UNPK(v0, rm[0]); P2_UNPK(v1, rm[1]);
                const float rn = (LOG2E * 0.125f) * __builtin_amdgcn_rsqf(xsum32(sumsq16(v0) + sumsq16(v1)) * (1.f / 64.f) + RMS_EPS);
#pragma unroll
                for (int r = 0; r < 16; ++r) { v0[r] *= rn * gm0[r]; v1[r] *= rn * gm1[r]; }
                unsigned char* qimg = ws + WS_QMEM + (size_t)(b * 4 + hq) * (256 * 8 * 512);
                store_q_tile(qimg, 8, qg, 0, v0, r32, hi); store_q_tile(qimg, 8, qg, 1, v1, r32, hi);
            }
#undef P2_UNPK
#undef P2_ROPE
        }
    }
    if (l == 0) {
        const int mbid = G >= 16 ? G - 1 - bid : bid;
        for (int task = mbid * NWAVES + wave; task < 128; task += G * NWAVES) {
            const int h = task & 3, tgm = (task >> 2) & 1, mt = (task >> 3) & 3, b = (task >> 5) & 1, lp = task >> 6;
            const bf16_t* row = (const bf16_t*)(ws + WS_MEMKV) + ((size_t)lp * 512 + b * 256 + mt * 64 + 32 * tgm + r32) * 512;
            f32x16 v0, v1, g0, g1;
            load_tile16(row + h * 64, hi, v0); load_tile16(row + h * 64 + 32, hi, v1);
            load_gain16(P.mkn_g + lp * 64, hi, g0); load_gain16(P.mkn_g + lp * 64 + 32, hi, g1);
            const float rn = __builtin_amdgcn_rsqf(xsum32(sumsq16(v0) + sumsq16(v1)) * (1.f / 64.f) + RMS_EPS);
#pragma unroll
            for (int r = 0; r < 16; ++r) { v0[r] *= rn * g0[r]; v1[r] *= rn * g1[r]; }
            unsigned char* kimg = ws + WS_KMEM + (size_t)((lp * 2 + b) * 4 + h) * (4 * 8 * 1024);
            store_k_tile(kimg, 8, mt, 32 * tgm + r32, 0, v0, hi); store_k_tile(kimg, 8, mt, 32 * tgm + r32, 1, v1, hi);
            transpose_v64(row + 256 + h * 64, ws + WS_VMEM + (size_t)((lp * 2 + b) * 4 + h) * (4 * 8 * 1024), mt, tgm, r32, hi);
        }
    }
}

constexpr int ATT_SLOT = 20480;
#define ATT_WAIT_BAR() asm volatile("s_waitcnt vmcnt(0) lgkmcnt(0)\n\ts_barrier" ::: "memory")

struct AttnEpi { int kind;   int ycol; float lam, oscale; const float* subln; const bf16_t* proj; bf16_t* Y; };

#define ATT_SBAR() __builtin_amdgcn_sched_barrier(0)
#ifndef FX_PWAVE
#define FX_PWAVE 0
#endif
#if FX_PROBE == 5 || FX_PROBE == 6 || FX_PROBE == 9
#define PROBE_ITEM_BEGIN() unsigned long long pi0_ = 0; if (opaque_bid() == 0 && wid == FX_PWAVE && NDS != 4) pi0_ = __builtin_amdgcn_s_memtime()
#define PROBE_ITEM_END() if (opaque_bid() == 0 && wid == FX_PWAVE && NDS != 4) { const unsigned long long pi1_ = __builtin_amdgcn_s_memtime(); if (lane == 0) { prb[NDS == 6 ? 4 : 6] += (unsigned)(pi1_ - pi0_); prb[NDS == 6 ? 5 : 7] += 1u; } }
#else
#define PROBE_ITEM_BEGIN()
#define PROBE_ITEM_END()
#endif
#if FX_PROBE == 2 || FX_PROBE == 3
#define PROBE_ON() (opaque_bid() == 0 && wid == FX_PWAVE)
#define PROBE_BAR_BEGIN() unsigned long long pb0_ = 0; if (PROBE_ON()) pb0_ = __builtin_amdgcn_s_memtime()
#define PROBE_BAR_END() unsigned long long pb1_ = 0; if (PROBE_ON()) { pb1_ = __builtin_amdgcn_s_memtime(); if (lane == 0) prb[0] += (unsigned)(pb1_ - pb0_); }
#define PROBE_ISSUE_END() if (PROBE_ON()) { const unsigned long long pb2_ = __builtin_amdgcn_s_memtime(); if (lane == 0) prb[1] += (unsigned)(pb2_ - pb1_); }
#else
#define PROBE_BAR_BEGIN()
#define PROBE_BAR_END()
#define PROBE_ISSUE_END()
#endif
#ifndef FX_ISSUE_HI
#define FX_ISSUE_HI 1
#endif
#ifndef FX_NT2C
#define FX_NT2C 1
#endif
#ifndef FX_PRIO
#define FX_PRIO 2
#endif
#ifndef FX_DIFF_PAIR
#define FX_DIFF_PAIR 0
#endif
#ifndef FX_RSMM_ALL
#define FX_RSMM_ALL 0
#endif
#ifndef FX_RSMM_NONE
#define FX_RSMM_NONE 0
#endif
#ifndef FX_DOT2
#define FX_DOT2 0
#endif
typedef __bf16 bf16x2n_t __attribute__((ext_vector_type(2)));
#define ATT_DOT2(pk, acc) __builtin_amdgcn_fdot2_f32_bf16(__builtin_bit_cast(bf16x2n_t, (unsigned)(pk)), __builtin_bit_cast(bf16x2n_t, 0x3f803f80u), (acc), false)
#ifndef FX_DMA_AT_BAR
#define FX_DMA_AT_BAR 1
#endif
struct AttIssue { const unsigned char *k0, *k1, *v; unsigned lds0, lane16; int wid, npw; };
template <int NCH, int NMAP>
__device__ __forceinline__ void att_issue(const AttIssue& c, int t, int slot) {
    constexpr int NKP = NMAP * NCH;
#pragma unroll
    for (int i = 0; i < 5; ++i) if (i < c.npw) { const int p = (c.wid & 3) + 4 * i;
        const unsigned char* s = (p < NCH) ? c.k0 + (size_t)t * (NCH * 1024) + p * 1024 : (p < NKP) ? c.k1 + (size_t)t * (NCH * 1024) + (p - NCH) * 1024 : c.v + (size_t)t * 8192 + (p - NKP) * 1024;
        glds16_off(s, c.lane16, (unsigned)__builtin_amdgcn_readfirstlane(c.lds0 + slot * ATT_SLOT + p * 1024)); }
}
template <int NDS, int NMAP, int VAR>
__device__ __forceinline__ void attn_item(f32x16 (&Scur)[2], f32x16 (&Snxt)[2], f32x16& O0, f32x16& O1, f32x16& L, const lds_u8* kb  ,
                                          const lds_u8* vb  , const bf16x8 (&qn)[NDS], int kslot, const AttIssue& ic, int tnext  , bool selrow  , float& lsum_v) {
    constexpr bool RSMM = FX_RSMM_ALL || (NDS != 6 && !FX_RSMM_NONE);
    constexpr int NQ4 = NDS / 2, NG = 3 + NQ4;
    float s0 = 0.f, s1 = 0.f;
    u32x4 pw[2];
    bf16x8 fr[2][NG];
    bf16x8 ones; { const short o1 = selrow ? (short)0x3f80 : (short)0; ones = (bf16x8){o1, o1, o1, o1, o1, o1, o1, o1}; }
#define ATT_VALU(q, lo, hi_) do { _Pragma("unroll") for (int o_ = (lo); o_ < (hi_); ++o_) { \
        if (o_ < 8) { const int r_ = 8 * ((q) & 1) + o_; const float x_ = Scur[(q) >> 1][r_]; Scur[(q) >> 1][r_] = (VAR == 1 || VAR == 7 || VAR >= 11) ? x_ : __builtin_amdgcn_exp2f(x_); } \
        else { const int r_ = 8 * ((q) & 1) + 2 * (o_ - 8); pw[(q) & 1][o_ - 8] = pk2(Scur[(q) >> 1][r_], Scur[(q) >> 1][r_ + 1]); if (!RSMM) { if (FX_DOT2) { if (o_ & 1) s1 = ATT_DOT2(pw[(q) & 1][o_ - 8], s1); else s0 = ATT_DOT2(pw[(q) & 1][o_ - 8], s0); } else { s0 += Scur[(q) >> 1][r_]; s1 += Scur[(q) >> 1][r_ + 1]; } } } } } while (0)
#define ATT_PIN(q) do { asm volatile("" : "+v"(Scur[(q) >> 1]), "+v"(pw[(q) & 1])); if (!RSMM) asm volatile("" : "+v"(s0), "+v"(s1)); } while (0)
#define ATT_FRAG(k, g) (VAR == 5 || VAR >= 11 || ((VAR == 2 || VAR == 10) && NDS == 6 && ((g) & 1))) ? qn[0] : ((g) < 2 ? *(const LAS bf16x8*)(vb + (k) * 2048 + (g) * 512) : *(const LAS bf16x8*)(kb + (((k) * NQ4 + (g) - 3) >> 1) * 2048 + (((k) * NQ4 + (g) - 3) & 1) * 512))
#pragma unroll
    for (int g = 0; g < NG; ++g) if (g != 2) fr[0][g] = ATT_FRAG(0, g);
    ATT_SBAR();
    ATT_VALU(0, 0, 12); ATT_PIN(0); ATT_SBAR();
#pragma unroll
    for (int k = 0; k < 4; ++k) {
        const bf16x8 pf = __builtin_bit_cast(bf16x8, pw[k & 1]);
#pragma unroll
        for (int g = 0; g < NG; ++g) {
            constexpr bool NOMM = (VAR == 8 || VAR >= 11);
            if (g == 0) { if (NOMM) asm volatile("" :: "v"(fr[k & 1][0]), "v"(pf)); else O0 = MFMA32(fr[k & 1][0], pf, O0); }
            else if (g == 1) { if (NOMM) asm volatile("" :: "v"(fr[k & 1][1])); else O1 = MFMA32(fr[k & 1][1], pf, O1); }
            else if (g == 2) { if (NOMM || !RSMM) asm volatile("" :: "v"(ones)); else L = MFMA32(ones, pf, L); }
            else { const int j = k * NQ4 + (g - 3), ds = j >> 1, hf = j & 1; if (NOMM) { asm volatile("" :: "v"(fr[k & 1][g])); if (ds == 0) { Snxt[hf] = f32x16{}; asm volatile("" : "+v"(Snxt[hf])); } } else Snxt[hf] = MFMA32(fr[k & 1][g], qn[ds], ds == 0 ? f32x16{} : Snxt[hf]); }
            if (k < 3) { if (g != 2) fr[(k + 1) & 1][g] = ATT_FRAG(k + 1, g); ATT_VALU(k + 1, (g * 12) / NG, ((g + 1) * 12) / NG); ATT_PIN(k + 1); }
            if (g == 0 && k == kslot && tnext >= 0) att_issue<NDS * 2, NMAP>(ic, tnext, tnext & 3);
            ATT_SBAR();
        }
    }
    if (!RSMM) lsum_v += s0 + s1;
#undef ATT_VALU
#undef ATT_PIN
#undef ATT_FRAG
}

template <int DQK, int NMAP, int VAR>
__device__ __forceinline__ void attn_unit(lds_u8* lds, const unsigned char* qimg0, const unsigned char* qimg1, const unsigned char* kimg0, const unsigned char* kimg1,
                                          const unsigned char* vimg, int NT, bool causal, int qb, int rowbase, const AttnEpi& E, int wv) {
    constexpr int NCH = DQK / 8, NKP = NMAP * NCH, NP = NKP + 8, NDS = DQK / 16;
    const int tid = opaque_tid(wv), lane = tid & 63, r32 = lane & 31, hi = lane >> 5;
    const int wid = __builtin_amdgcn_readfirstlane(tid >> 6);
    const unsigned lds0 = (unsigned)(uintptr_t)lds;
#if FX_PRIO
    if ((FX_PRIO == 1) ? (wid >= 4) : (wid < 4)) __builtin_amdgcn_s_setprio(1);
#endif
#if FX_PROBE == 7 || FX_PROBE == 8
    volatile LAS unsigned* prbu = (volatile LAS unsigned*)(lds + 135168 + 64); const bool pu_on = opaque_bid() == 0 && wid == 0; unsigned long long pu0 = 0; if (pu_on) pu0 = __builtin_amdgcn_s_memtime();
#endif
    bf16x8 qf[NMAP][NDS];
#pragma unroll
    for (int m = 0; m < NMAP; ++m)
#pragma unroll
        for (int ds = 0; ds < NDS; ++ds) qf[m][ds] = __builtin_nontemporal_load((const GAS bf16x8*)((m ? qimg1 : qimg0) + ((size_t)(qb * 8 + wid) * NCH + 2 * ds + hi) * 512 + r32 * 16));
    f32x16 O[NMAP][2], Lacc[1]; float lsum[NMAP];
    const int qw0 = qb * 256 + 32 * wid;
    const int tlast = (VAR == 9 && wid >= 4) ? -1 : causal ? (qw0 + 31) >> 6 : NT - 1;
    const int npw = (FX_ISSUE_HI ? wid >= 4 : wid < 4) ? (NP - (wid & 3) + 3) >> 2 : 0;
    volatile LAS unsigned* prb = (volatile LAS unsigned*)(lds + 135168 + 64); (void)prb;
    AttIssue ic; ic.k0 = kimg0; ic.k1 = kimg1; ic.v = vimg; ic.lds0 = lds0; ic.lane16 = lane * 16; ic.wid = wid; ic.npw = npw;
#define ATT_ISSUE(t, slot) att_issue<NCH, NMAP>(ic, (t), (slot))
#define ATT_SLOTOF(t) ((!FX_DIFF_PAIR && NMAP == 2) ? ((unsigned)(t) & 3u) : ((unsigned)(t) % 6u))
#define ATT_BAR(t) do { PROBE_BAR_BEGIN(); if (VAR == 4 || VAR == 6 || VAR >= 11) { if (VAR == 4) __builtin_amdgcn_s_barrier(); break; } if ((VAR == 3 || VAR == 10) && NDS == 6 && (t) >= 0 && ((t) & 2)) break;   \
        if ((t) < 0 && NT > 2) { if (npw == 5) asm volatile("s_waitcnt vmcnt(10) lgkmcnt(0)\n\ts_barrier" ::: "memory"); else if (npw == 4) asm volatile("s_waitcnt vmcnt(8) lgkmcnt(0)\n\ts_barrier" ::: "memory"); else asm volatile("s_waitcnt lgkmcnt(0)\n\ts_barrier" ::: "memory"); } \
        else ATT_WAIT_BAR(); PROBE_BAR_END(); \
        if ((t) >= 0) { if ((t) + 4 < NT) ATT_ISSUE((t) + 4, ATT_SLOTOF((t) + 4)); if ((t) + 5 < NT) ATT_ISSUE((t) + 5, ATT_SLOTOF((t) + 5)); } PROBE_ISSUE_END(); } while (0)
#define ATT_BAR1(t) do { if ((t) + 2 < NT) { if (npw == 5) asm volatile("s_waitcnt vmcnt(5) lgkmcnt(0)\n\ts_barrier" ::: "memory"); else if (npw == 4) asm volatile("s_waitcnt vmcnt(4) lgkmcnt(0)\n\ts_barrier" ::: "memory"); else asm volatile("s_waitcnt lgkmcnt(0)\n\ts_barrier" ::: "memory"); } \
        else ATT_WAIT_BAR(); if ((t) + 3 < NT) ATT_ISSUE((t) + 3, ((t) + 3) & 3); } while (0)
    const int lane_off = hi * 1024 + r32 * 16;
#define ATT_KB(tk, mk) (lds + ATT_SLOTOF(tk) * ATT_SLOT + (mk) * (NCH * 1024) + lane_off)
#define ATT_VB(tv) (lds + ATT_SLOTOF(tv) * ATT_SLOT + NKP * 1024 + lane_off)
    f32x16 SA[2], SB[2];
    if (!FX_DIFF_PAIR && NMAP == 2) { ATT_ISSUE(0, 0); ATT_ISSUE(1, 1); ATT_BAR1(-1); }
    else { if (VAR != 4 && VAR != 6 && VAR < 11) { ATT_ISSUE(0, 0); ATT_ISSUE(1, 1); if (NT > 2) { ATT_ISSUE(2, 2); ATT_ISSUE(3, 3); } }
           ATT_BAR(-2); }
#pragma unroll
    for (int m = 0; m < NMAP; ++m)
#pragma unroll
        for (int ds = 0; ds < NDS; ++ds) asm volatile("" : "+v"(qf[m][ds]));
    { const lds_u8* kb_ = ATT_KB(0, 0);
#pragma unroll
      for (int ds = 0; ds < NDS; ++ds) { SA[0] = MFMA32(*(const LAS bf16x8*)(kb_ + ds * 2048), qf[0][ds], ds == 0 ? f32x16{} : SA[0]); SA[1] = MFMA32(*(const LAS bf16x8*)(kb_ + ds * 2048 + 512), qf[0][ds], ds == 0 ? f32x16{} : SA[1]); } }
    ATT_SBAR();
#define ATT_ITEM(M, MN, CUR, NXT, t, kb_, DOISSUE) do { PROBE_ITEM_BEGIN(); attn_item<NDS, NMAP, VAR>(CUR, NXT, O[M][0], O[M][1], Lacc[0], kb_, ATT_VB(t), qf[MN], wid & 3, ic, -1, NMAP == 1 || ((r32 >> 4) == (M)), lsum[M]); PROBE_ITEM_END(); } while (0)
    u32x4 zc[2][2];
#define ATT_ZPRE() do { const int lz_ = opaque_tid(wv) & 63; const unsigned char* zr_ = (const unsigned char*)E.proj + PIMG_OFF((rowbase >> 5) + wid, (OFF_Z + E.ycol) / 8 + (lz_ >> 5), lz_ & 31);   \
        _Pragma("unroll") for (int dt_ = 0; dt_ < 2; ++dt_) _Pragma("unroll") for (int p_ = 0; p_ < 2; ++p_) zc[dt_][p_] = FX_NT2C ? __builtin_nontemporal_load((const GAS u32x4*)(zr_ + (4 * dt_ + 2 * p_) * 512)) : *(const GAS u32x4*)(zr_ + (4 * dt_ + 2 * p_) * 512); } while (0)
#define ATT_TAIL(t, S0) do { ATT_ZPRE(); f32x16 T_[2]; T_[0] = S0[0]; T_[1] = S0[1]; const lds_u8* vb_ = ATT_VB(t); const int l2_ = opaque_tid(wv) & 63, hi2_ = l2_ >> 5; const int kq_ = 64 * (t) - (qw0 + (l2_ & 31)); \
        _Pragma("unroll") for (int m_ = 0; m_ < NMAP; ++m_) { asm volatile("" ::: "memory");   \
            if (m_ > 0) { const lds_u8* kb_ = ATT_KB(t, m_); _Pragma("unroll") for (int ds_ = 0; ds_ < NDS; ++ds_) { \
                T_[0] = MFMA32(*(const LAS bf16x8*)(kb_ + ds_ * 2048), qf[m_][ds_], ds_ == 0 ? f32x16{} : T_[0]); T_[1] = MFMA32(*(const LAS bf16x8*)(kb_ + ds_ * 2048 + 512), qf[m_][ds_], ds_ == 0 ? f32x16{} : T_[1]); } } \
            float s_ = 0.f; \
            _Pragma("unroll") for (int r_ = 0; r_ < 16; ++r_) { float x0_ = T_[0][r_], x1_ = T_[1][r_]; \
                if (causal) { const int key_ = kq_ + crow(r_, hi2_); if (key_ > 0) x0_ = -INFINITY; if (key_ + 32 > 0) x1_ = -INFINITY; } \
                x0_ = __builtin_amdgcn_exp2f(x0_); x1_ = __builtin_amdgcn_exp2f(x1_); s_ += x0_ + x1_; T_[0][r_] = x0_; T_[1][r_] = x1_; } \
            lsum[m_] += s_; \
            _Pragma("unroll") for (int k_ = 0; k_ < 4; ++k_) { const bf16x8 pf_ = __builtin_bit_cast(bf16x8, pack8(T_[k_ >> 1], k_ & 1)); \
                O[m_][0] = MFMA32(*(const LAS bf16x8*)(vb_ + k_ * 2048), pf_, O[m_][0]); O[m_][1] = MFMA32(*(const LAS bf16x8*)(vb_ + k_ * 2048 + 512), pf_, O[m_][1]); } } } while (0)
    {
        float zf = 0.f; asm volatile("" : "+v"(zf));
#pragma unroll
        for (int r = 0; r < 16; ++r) { Lacc[0][r] = zf;
#pragma unroll
            for (int m = 0; m < NMAP; ++m) { O[m][0][r] = zf; O[m][1][r] = zf; } }
#pragma unroll
        for (int m = 0; m < NMAP; ++m) lsum[m] = 0.f;
    }
#if FX_PROBE == 7
    if (pu_on) { const unsigned long long t_ = __builtin_amdgcn_s_memtime(); if (lane == 0) { prbu[4] += (unsigned)(t_ - pu0); prbu[5] += 1u; } }
#endif
    if (tlast < 0) { if (!FX_DIFF_PAIR && NMAP == 2) { for (int t = 0; t < NT; ++t) ATT_BAR1(t); } else { for (int t = 0; t < NT; t += 2) ATT_BAR(t); } }
    else if (FX_DIFF_PAIR && NMAP == 2) {
        int t = 0;
        for (; t <= tlast; t += 2) { ATT_BAR(t);
            const int tend = (t + 2 <= tlast) ? t + 2 : tlast;
#pragma unroll 1
            for (int u = t; u < tend; ++u) { ATT_ITEM(0, NMAP - 1, SA, SB, u, ATT_KB(u, NMAP - 1), false); ATT_ITEM(NMAP - 1, 0, SB, SA, u, ATT_KB(u + 1, 0), false); }
            if (tend == tlast) { ATT_TAIL(tlast, SA); t += 2; break; } }
        for (; t < NT; t += 2) ATT_BAR(t);
    }
    else if (NMAP == 2) {
        int t = 0;
        for (; t < tlast; ++t) { ATT_BAR1(t); ATT_ITEM(0, NMAP - 1, SA, SB, t, ATT_KB(t, NMAP - 1), false); ATT_ITEM(NMAP - 1, 0, SB, SA, t, ATT_KB(t + 1, 0), false); }
        ATT_BAR1(t); ATT_TAIL(t, SA);
        for (++t; t < NT; ++t) ATT_BAR1(t);
    } else {
        int t = 0;
        for (; t + 2 <= tlast; t += 2) { ATT_BAR(t); ATT_ITEM(0, 0, SA, SB, t, ATT_KB(t + 1, 0), false); ATT_ITEM(0, 0, SB, SA, t + 1, ATT_KB(t + 2, 0), false); }
        ATT_BAR(t);
        if (t < tlast) { ATT_ITEM(0, 0, SA, SB, t, ATT_KB(t + 1, 0), false); ATT_TAIL(t + 1, SB); }
        else ATT_TAIL(t, SA);
        for (t += 2; t < NT; t += 2) ATT_BAR(t);
    }
#undef ATT_TAIL
#undef ATT_ZPRE
#undef ATT_ITEM
#undef ATT_BAR
#undef ATT_BAR1
#undef ATT_SLOTOF
#undef ATT_KB
#undef ATT_VB
#undef ATT_ISSUE
#if FX_PROBE == 8
    if (pu_on) pu0 = __builtin_amdgcn_s_memtime();
#endif
    const int l3 = opaque_tid(wv) & 63, r32e = l3 & 31, hie = l3 >> 5;
    const int T = rowbase + 32 * wid + r32e;
    f32x16 o[2];
    if (NMAP == 1) {
        const float inv = __builtin_amdgcn_rcpf(xsum32(lsum[0]) + Lacc[0][0]);
#pragma unroll
        for (int dt = 0; dt < 2; ++dt)
#pragma unroll
            for (int r = 0; r < 16; ++r) o[dt][r] = O[0][dt][r] * inv;
    } else {
        const float i0 = __builtin_amdgcn_rcpf(xsum32(lsum[0]) + Lacc[0][0]), i1 = E.lam * __builtin_amdgcn_rcpf(xsum32(lsum[NMAP - 1]) + Lacc[0][8]);
        float ss = 0.f;
#pragma unroll
        for (int dt = 0; dt < 2; ++dt)
#pragma unroll
            for (int r = 0; r < 16; ++r) { const float v = O[0][dt][r] * i0 - O[NMAP - 1][dt][r] * i1; o[dt][r] = v; ss += v * v; }
        const float rn = E.oscale * __builtin_amdgcn_rsqf(xsum32(ss) * (1.f / 64.f) + RMS_EPS);
#pragma unroll
        for (int dt = 0; dt < 2; ++dt) { f32x16 g; load_gain16(E.subln + 32 * dt, hie, g);
#pragma unroll
            for (int r = 0; r < 16; ++r) o[dt][r] *= rn * g[r]; }
    }
    unsigned char* yrow = (unsigned char*)(E.Y + (size_t)T * 1024 + E.ycol) + 16 * hie;
#pragma unroll
    for (int dt = 0; dt < 2; ++dt) {
        u32x2 zraw[4];
#pragma unroll
        for (int p = 0; p < 2; ++p) {
            const auto rx = __builtin_amdgcn_permlane32_swap(zc[dt][p].x, zc[dt][p].z, false, false), ry = __builtin_amdgcn_permlane32_swap(zc[dt][p].y, zc[dt][p].w, false, false);
            zraw[2 * p].x = rx[0]; zraw[2 * p].y = ry[0]; zraw[2 * p + 1].x = rx[1]; zraw[2 * p + 1].y = ry[1];
        }
        f32x16 z;
#pragma unroll
        for (int g = 0; g < 4; ++g) { z[4 * g] = bflo(zraw[g].x); z[4 * g + 1] = bfhi(zraw[g].x); z[4 * g + 2] = bflo(zraw[g].y); z[4 * g + 3] = bfhi(zraw[g].y); }
        u32x2 w[4];
#pragma unroll
        for (int g = 0; g < 4; ++g) {
            float y[4];
#pragma unroll
            for (int e = 0; e < 4; ++e) { const float zz = z[4 * g + e]; y[e] = o[dt][4 * g + e] * zz * __builtin_amdgcn_rcpf(1.0f + __expf(-zz)); }
            w[g].x = pk2(y[0], y[1]); w[g].y = pk2(y[2], y[3]);
        }
#pragma unroll
        for (int p = 0; p < 2; ++p) {
            const auto rx = __builtin_amdgcn_permlane32_swap(w[2 * p].x, w[2 * p + 1].x, false, false), ry = __builtin_amdgcn_permlane32_swap(w[2 * p].y, w[2 * p + 1].y, false, false);
            u32x4 s; s.x = rx[0]; s.y = ry[0]; s.z = rx[1]; s.w = ry[1];
            if (VAR == 0 || lsum[0] == 12345.678f) *(GAS u32x4*)(yrow + (32 * dt + 16 * p) * 2) = s;
        }
    }
#if FX_PRIO
    __builtin_amdgcn_s_setprio(0);
#endif
    asm volatile("s_waitcnt lgkmcnt(0)\n\ts_barrier" ::: "memory");
#if FX_PROBE == 8
    if (pu_on) { const unsigned long long t_ = __builtin_amdgcn_s_memtime(); if (opaque_tid(wv) == 0) { prbu[4] += (unsigned)(t_ - pu0); prbu[5] += 1u; } }
#endif
}

#ifndef FX_VAR
#define FX_VAR 0
#endif
template <int VAR>
__device__ __forceinline__ void p3_attention(KP P, int l, lds_u8* lds, int rep, int wv) {
    unsigned char* ws = opaque_ptr(P.ws);
    const float* SC = (const float*)(ws + WS_CTL + CTL_SC) + l * 16;
    unsigned* qctr = (unsigned*)(ws + WS_CTL + CTL_Q + (2 * l + rep) * 256);
    LAS unsigned* sh = (LAS unsigned*)(lds + 135168 + 16);
    AttnEpi E; E.proj = (const bf16_t*)(ws + WS_PROJ); E.Y = (bf16_t*)(ws + WS_Y); E.lam = __uint_as_float(__builtin_amdgcn_readfirstlane(__float_as_uint(SC[SC_LAM]))); E.oscale = __uint_as_float(__builtin_amdgcn_readfirstlane(__float_as_uint(SC[SC_OSCALE]))); E.subln = P.subln_g + l * 64;
#define ATTN_CALL(D, N) attn_unit<D, N, VAR>
#if FX_PROBE
    if (l == 0 && rep == 0 && opaque_bid() == 0 && opaque_tid(wv) == 0) { volatile LAS unsigned long long* prq = (volatile LAS unsigned long long*)(lds + 135168 + 128); prq[0] = __builtin_amdgcn_s_memtime(); prq[1] = __builtin_amdgcn_s_memrealtime(); }
#endif
    bool first_unit = true;
    for (;;) {
#if FX_PROBE == 20
        const bool pq_on = opaque_bid() == 0 && (opaque_tid(wv) >> 6) == 0; unsigned long long pq0 = 0; if (pq_on) pq0 = __builtin_amdgcn_s_memtime();
#endif
        int i;
        if (first_unit) { i = opaque_bid(); first_unit = false; }
        else {
            if (opaque_tid(wv) == 0) sh[0] = atomicAdd(qctr, 1u);
            __syncthreads();
            i = (int)sh[0] + opaque_grid();
            __syncthreads();
        }
#if FX_PROBE == 20
        if (pq_on) { const unsigned long long t_ = __builtin_amdgcn_s_memtime(); if ((opaque_tid(wv) & 63) == 0) { volatile LAS unsigned* prbq = (volatile LAS unsigned*)(lds + 135168 + 64); prbq[4] += (unsigned)(t_ - pq0); prbq[5] += 1u; } }
#endif
        if (i >= 1024) {
#if FX_PROBE
            if (l == 0 && rep == 0 && opaque_bid() == 0 && opaque_tid(wv) == 0) { volatile LAS unsigned* prb = (volatile LAS unsigned*)(lds + 135168 + 64); volatile LAS unsigned long long* prq = (volatile LAS unsigned long long*)(lds + 135168 + 128);
                prb[2] = (unsigned)(__builtin_amdgcn_s_memtime() - prq[0]); prb[3] = (unsigned)(__builtin_amdgcn_s_memrealtime() - prq[1]); }
#endif
            break; }
        if (i < 768) {
            const int qb = 31 - i / 24, j = i % 24;
            if (j < 8) {
                const int b = j >> 2, h = j & 3;
                E.kind = 1; E.ycol = 512 + h * 64;
                const unsigned char* q0 = ws + WS_QDIF + (size_t)(b * 8 + 2 * h) * (256 * 4 * 512);
                const unsigned char* k0 = ws + WS_KDIF + (size_t)(b * 8 + 2 * h) * (128 * 4 * 1024);
#ifdef FX_NODIFF
                if (rep == 0)
#endif
                ATTN_CALL(32, 2)(lds, q0, q0 + 256 * 4 * 512, k0, k0 + 128 * 4 * 1024, ws + WS_VDIF + (size_t)(b * 4 + h) * (128 * 8 * 1024), 4 * qb + 4, true, qb, b * SEQ + qb * 256, E, wv);
            } else {
                const int bh = j - 8, b = bh >> 3, h = bh & 7;
                E.kind = 0; E.ycol = h * 64;
                const unsigned char* q0 = opaque_ptr((unsigned char*)P.out) + OUT_QMLA + (size_t)bh * (256 * 12 * 512);
                const unsigned char* k0 = opaque_ptr((unsigned char*)P.out) + OUT_KMLA + (size_t)bh * (128 * 12 * 1024);
#ifdef FX_NOMLA
                if (rep == 0)
#endif
                ATTN_CALL(96, 1)(lds, q0, q0, k0, k0, ws + WS_VMLA + (size_t)bh * (128 * 8 * 1024), 4 * qb + 4, true, qb, b * SEQ + qb * 256, E, wv);
            }
        } else {
            const int u = i - 768, s = u >> 5, qb = u & 31, b = s >> 2, h = s & 3;
            E.kind = 2; E.ycol = 768 + h * 64;
            const unsigned char* q0 = ws + WS_QMEM + (size_t)s * (256 * 8 * 512);
            const unsigned char* k0 = ws + WS_KMEM + (size_t)((l * 2 + b) * 4 + h) * (4 * 8 * 1024);
            ATTN_CALL(64, 1)(lds, q0, q0, k0, k0, ws + WS_VMEM + (size_t)((l * 2 + b) * 4 + h) * (4 * 8 * 1024), 4, false, qb, b * SEQ + qb * 256, E, wv);
        }
    }
}

#ifndef FX_G_ALIGN
#define FX_G_ALIGN true
#endif
#ifndef FX_G_SP2
#define FX_G_SP2 true
#endif
struct SchedP1 {
    int G, c, l; bool mem; int e0, e1;
    __device__ __forceinline__ bool next(int i, pg8::Unit& u) const {
        const long e = (long)i * G + c + e0;
        if (e >= e1) return false;
        long L = e;
        if (mem) { if (e < 8) { const int k = (int)e; u.pm = 64 + (k & 1); u.pn = 20 + (k >> 1); return true; } L = e - 8; }
        { const int w0 = (int)L, wgid = (w0 % 8) * 80 + w0 / 8; const int gid = wgid / 80, rem = wgid % 80; u.pm = gid * 8 + (rem % 8); u.pn = rem / 8 + 10 * l; return true; }
    }
    __device__ __forceinline__ void a_ready(const pg8::Unit&) const {}
    __device__ __forceinline__ void done(const pg8::Unit&) const {}
};
struct EpiProj {
    static constexpr bool PERM = true, AFTER_DRAIN = false;
    bf16_t* proj; bf16_t* memkv; const float* rowss; int l;
    __device__ __forceinline__ void operator()(const pg8::f32x4 (&acc)[2][2][4][2], const pg8::Unit& u, int wr, int wc, int fr, int fq) const {
        bf16_t* base; int ldc, row0, colt;
        if (u.pm < 64) { base = proj; ldc = PROJ_PITCH; row0 = u.pm * 256; colt = (u.pn - 10 * l) * 256; }
        else { const int k = u.pn - 20; base = memkv + (size_t)(k >> 1) * 512 * 512; ldc = 512; row0 = (u.pm - 64) * 256; colt = (k & 1) * 256; }
        row0 += wr * 64 + fr; const int col0 = colt + wc * 32 + 8 * fq;
        const float* ssp = rowss + (size_t)(u.pm * 256 + wr * 64 + fr) * 16 + 4 * fq;
        pg8::f32x4 q4[2][4]; float rs[2][4];
#pragma unroll
        for (int ai = 0; ai < 2; ++ai)
#pragma unroll
            for (int m = 0; m < 4; ++m) q4[ai][m] = *(const GAS pg8::f32x4*)(ssp + (size_t)(ai * 128 + m * 16) * 16);
        __builtin_amdgcn_sched_barrier(0);
#pragma unroll
        for (int ai = 0; ai < 2; ++ai)
#pragma unroll
            for (int m = 0; m < 4; ++m) { float ss = (q4[ai][m][0] + q4[ai][m][1]) + (q4[ai][m][2] + q4[ai][m][3]); ss = xsum16_32(ss); rs[ai][m] = __builtin_amdgcn_rsqf(ss * (1.f / 1024.f) + RMS_EPS); }
        __builtin_amdgcn_sched_barrier(0);
#pragma unroll
        for (int ai = 0; ai < 2; ++ai)
#pragma unroll
            for (int m = 0; m < 4; ++m) { const int row = row0 + ai * 128 + m * 16; bf16_t* rowp = base + (size_t)row * ldc + col0;
#pragma unroll
                for (int bj = 0; bj < 2; ++bj) { const pg8::f32x4 v0 = acc[ai][bj][m][0] * rs[ai][m], v1 = acc[ai][bj][m][1] * rs[ai][m];
                    u32x4 w; w.x = pk2(v0[0], v0[1]); w.y = pk2(v0[2], v0[3]); w.z = pk2(v1[0], v1[1]); w.w = pk2(v1[2], v1[3]);
                    const int col = col0 + bj * 128;
                    if (u.pm < 64) *(GAS u32x4*)((unsigned char*)proj + PIMG_OFF(row >> 5, col >> 3, row & 31)) = w;
                    else *(GAS u32x4*)(rowp + bj * 128) = w; } }
    }
};
#ifndef FX_NT_EPI
#define FX_NT_EPI 0
#endif
#ifndef FX_NT2
#define FX_NT2 1
#endif
struct EpiResid {
    static constexpr bool PERM = true, AFTER_DRAIN = false;
    const float* basef; const bf16_t* baseh; float* out; bf16_t* xb; float* rowss;
    template<bool H>
    __device__ __forceinline__ void run(const pg8::f32x4 (&acc)[2][2][4][2], const pg8::Unit& u, int wr, int wc, int fr, int fq) const {
        const int col0 = u.pn * 256 + wc * 32 + 8 * fq;
#pragma unroll
        for (int ai = 0; ai < 2; ++ai) {
            pg8::f32x4 bs[4][2][2];
            if constexpr (H) {
                u32x4 hb[4][2];
#pragma unroll
                for (int m = 0; m < 4; ++m) { const size_t off = (size_t)(u.pm * 256 + ai * 128 + wr * 64 + m * 16 + fr) * 1024 + col0;
#pragma unroll
                    for (int bj = 0; bj < 2; ++bj) hb[m][bj] = FX_NT2 ? __builtin_nontemporal_load((const GAS u32x4*)(baseh + off + bj * 128)) : *(const GAS u32x4*)(baseh + off + bj * 128); }
                __builtin_amdgcn_sched_barrier(0);
#pragma unroll
                for (int m = 0; m < 4; ++m)
#pragma unroll
                    for (int bj = 0; bj < 2; ++bj) { const u32x4 w = hb[m][bj];
                        bs[m][bj][0][0] = __uint_as_float(w.x << 16); bs[m][bj][0][1] = __uint_as_float(w.x & 0xffff0000u); bs[m][bj][0][2] = __uint_as_float(w.y << 16); bs[m][bj][0][3] = __uint_as_float(w.y & 0xffff0000u);
                        bs[m][bj][1][0] = __uint_as_float(w.z << 16); bs[m][bj][1][1] = __uint_as_float(w.z & 0xffff0000u); bs[m][bj][1][2] = __uint_as_float(w.w << 16); bs[m][bj][1][3] = __uint_as_float(w.w & 0xffff0000u); }
            } else {
#pragma unroll
                for (int m = 0; m < 4; ++m) { const size_t off = (size_t)(u.pm * 256 + ai * 128 + wr * 64 + m * 16 + fr) * 1024 + col0;
#pragma unroll
                    for (int bj = 0; bj < 2; ++bj) { if (FX_NT2) { bs[m][bj][0] = __builtin_nontemporal_load((const GAS pg8::f32x4*)(basef + off + bj * 128)); bs[m][bj][1] = __builtin_nontemporal_load((const GAS pg8::f32x4*)(basef + off + bj * 128 + 4)); } else { bs[m][bj][0] = *(const GAS pg8::f32x4*)(basef + off + bj * 128); bs[m][bj][1] = *(const GAS pg8::f32x4*)(basef + off + bj * 128 + 4); } } }
                __builtin_amdgcn_sched_barrier(0);
            }
#pragma unroll
            for (int m = 0; m < 4; ++m) { const int row = u.pm * 256 + ai * 128 + wr * 64 + m * 16 + fr; const size_t off = (size_t)row * 1024 + col0; float ss = 0.f;
#pragma unroll
                for (int bj = 0; bj < 2; ++bj) {
                    const pg8::f32x4 o0 = bs[m][bj][0] + acc[ai][bj][m][0], o1 = bs[m][bj][1] + acc[ai][bj][m][1];
                    if (out) { *(GAS pg8::f32x4*)(out + off + bj * 128) = o0; *(GAS pg8::f32x4*)(out + off + bj * 128 + 4) = o1; }
                    if (xb) { ss += ((o0[0] * o0[0] + o0[1] * o0[1]) + (o0[2] * o0[2] + o0[3] * o0[3])) + ((o1[0] * o1[0] + o1[1] * o1[1]) + (o1[2] * o1[2] + o1[3] * o1[3]));
                        u32x4 w; w.x = pk2(o0[0], o0[1]); w.y = pk2(o0[2], o0[3]); w.z = pk2(o1[0], o1[1]); w.w = pk2(o1[2], o1[3]); *(GAS u32x4*)(xb + off + bj * 128) = w; } }
                if (xb) { ss = xsum16_32(ss); if (fq == 0) *(GAS float*)(rowss + (size_t)row * 16 + 4 * u.pn + wc) = ss; } }
            __builtin_amdgcn_sched_barrier(0);
        }
    }
    __device__ __forceinline__ void operator()(const pg8::f32x4 (&acc)[2][2][4][2], const pg8::Unit& u, int wr, int wc, int fr, int fq) const {
        if (baseh) run<true>(acc, u, wr, wc, fr, fq); else run<false>(acc, u, wr, wc, fr, fq);
    }
};

#ifndef FX_DEFERW
#define FX_DEFERW 1
#endif
#ifndef FX_TOK_FIRST
#define FX_TOK_FIRST 1
#endif
#ifndef FX_P1B_SP2ALT
#define FX_P1B_SP2ALT 0
#endif
constexpr int P1_SPLIT = 512;
__device__ __forceinline__ int p1_entries(int l) { return 640 + (l == 0 ? 8 : 0); }
__device__ __forceinline__ void p1_inproj(KP P, int l, lds_u8* lds, int wv, int part) {
    unsigned char* ws = opaque_ptr(P.ws);
    pg8::Gemm g{(const pg8::bf16_t*)(ws + WS_XB), (const pg8::bf16_t*)(ws + WS_WTIN), 16896, 6144, 1024};
    SchedP1 S{opaque_grid(), opaque_bid(), l, l == 0, part == 0 ? 0 : P1_SPLIT, part == 0 ? P1_SPLIT : p1_entries(l)};
    EpiProj E{(bf16_t*)(ws + WS_PROJ), (bf16_t*)(ws + WS_MEMKV), (const float*)(ws + WS_ROWSS), l};
    if (FX_P1B_SP2ALT && part == 1) pg8::gemm_phase<EpiProj, SchedP1, FX_G_ALIGN, !FX_G_SP2>(lds, g, S, E, wv);
    else pg8::gemm_phase<EpiProj, SchedP1, FX_G_ALIGN, FX_G_SP2>(lds, g, S, E, wv);
}
#ifndef FX_RESID_BF16
#define FX_RESID_BF16 1
#endif
__device__ __forceinline__ void p4_outproj(KP P, int l, lds_u8* lds, int wv) {
    unsigned char* ws = opaque_ptr(P.ws);
    pg8::Gemm g{(const pg8::bf16_t*)(ws + WS_Y), (const pg8::bf16_t*)(ws + WS_WTOUT) + (size_t)l * 1024 * 1024, NTOK, 1024, 1024};
    pg8::StaticOrder S; S.init(NTOK, 1024, opaque_grid(), opaque_bid());
    const bool last = l + 1 == DEPTH;
    EpiResid E{(l == 0 && !FX_RESID_BF16) ? P.x : nullptr, (l == 0 && !FX_RESID_BF16) ? nullptr : (const bf16_t*)(ws + WS_XB), last ? P.out : nullptr, last ? nullptr : (bf16_t*)(ws + WS_XB), (float*)(ws + WS_ROWSS)};
    pg8::gemm_phase<EpiResid, pg8::StaticOrder, FX_G_ALIGN, FX_G_SP2>(lds, g, S, E, wv);
}

constexpr int LDS_BYTES = 147456;
constexpr int LDS_MISC = 135168;
#ifndef FX_CG_ONLY
#define FX_CG_ONLY 0
#endif
__global__ void __launch_bounds__(NTHREADS, 2) fwd_kernel(Params P_arg) {
    extern __shared__ __attribute__((aligned(16))) unsigned char lds_raw[];
    lds_u8* lds = (lds_u8*)lds_raw;
#ifndef FX_NOCG
    cg::grid_group grid = cg::this_grid();
#endif
    const int wv = __builtin_amdgcn_readfirstlane(threadIdx.x >> 6);
    volatile LAS unsigned* misc = (volatile LAS unsigned*)(lds + LDS_MISC);
    if (threadIdx.x < 32) misc[threadIdx.x] = 0u;
    __syncthreads();
    if (blockIdx.x == 0) { unsigned* ctl = (unsigned*)(P_arg.ws + WS_CTL);
        for (int i = threadIdx.x; i < 1024 / 4; i += NTHREADS) ctl[CTL_Q / 4 + i] = 0u;
        for (int i = threadIdx.x; i < XCD_BAR_WORDS; i += NTHREADS) ctl[CTL_BAR / 4 + i] = 0u; }
#ifndef FX_DUP
#define FX_DUP -1
#endif
#ifndef FX_VAR
#define FX_VAR 0
#endif
#ifndef FX_XBAR
#define FX_XBAR 0
#endif
#ifndef FX_SYNC_FIRST
#define FX_SYNC_FIRST 1
#endif
#define FX_KP() (*launder_kp())
#define FX_BAR() xb::xcd_barrier(bar, wv)
#if FX_SYNC_FIRST
    grid.sync();
    xb::XcdBarrier bar = xb::xcd_barrier_post((unsigned*)(P_arg.ws + WS_CTL + CTL_BAR), misc + 8);
    p0_prologue(FX_KP(), lds, wv);
    FX_BAR();
#else
    p0_prologue(FX_KP(), lds, wv);
    grid.sync();
    xb::XcdBarrier bar = xb::xcd_barrier_post((unsigned*)(P_arg.ws + WS_CTL + CTL_BAR), misc + 8);
#endif
    if (FX_DUP == 0) { p0_prologue(FX_KP(), lds, wv); FX_BAR(); }
    for (int xb_ = 0; xb_ < FX_XBAR; ++xb_) FX_BAR();
#pragma unroll 1
    for (int l = 0; l < DEPTH; ++l) {
#ifndef FX_SKIP1
        p1_inproj(FX_KP(), l, lds, wv, 0);
#endif
        FX_BAR();
        if (FX_DUP == 1) { p1_inproj(FX_KP(), l, lds, wv, 0); FX_BAR(); }
        if (FX_DUP == 2) { if (FX_VAR != 11) p2_mla(FX_KP(), l, lds, wv); if (FX_VAR != 10) p2_tokens<0>(FX_KP(), l, wv, 0); FX_BAR(); }
#ifndef FX_SKIP2
        p1_inproj(FX_KP(), l, lds, wv, 1);
#if FX_TOK_FIRST
        p2_tokens<0>(FX_KP(), l, wv, p1_entries(l) - P1_SPLIT);
        p2_mla(FX_KP(), l, lds, wv);
#else
        p2_mla(FX_KP(), l, lds, wv);
        p2_tokens<0>(FX_KP(), l, wv, p1_entries(l) - P1_SPLIT);
#endif
#if FX_DEFERW
        if (l == 0) p0_weights_deferred(FX_KP(), lds, wv, p1_entries(l) - P1_SPLIT);
#endif
#endif
        FX_BAR();
#ifndef FX_SKIP3
        p3_attention<0>(FX_KP(), l, lds, 0, wv);
#endif
        FX_BAR();
        if (FX_DUP == 3) { p3_attention<FX_VAR>(FX_KP(), l, lds, 1, wv); FX_BAR(); }
#ifndef FX_SKIP4
        p4_outproj(FX_KP(), l, lds, wv);
#endif
        if (l + 1 < DEPTH) FX_BAR();
        if (FX_DUP == 4 && l == 0) { p4_outproj(FX_KP(), l, lds, wv); FX_BAR(); }
    }
#if FX_PROBE
    if (opaque_bid() == 0 && opaque_tid(wv) == 0) {
        volatile LAS unsigned* prb = (volatile LAS unsigned*)(lds + 135168 + 64);
        unsigned ticks = 0;
        if (FX_PROBE == 1) ticks = (unsigned)((unsigned long long)prb[2] * 1000ull / (prb[3] ? prb[3] : 1u));
        if (FX_PROBE == 2) ticks = (unsigned)((unsigned long long)prb[0] * 10000ull / (prb[2] ? prb[2] : 1u));
        if (FX_PROBE == 3) ticks = (unsigned)((unsigned long long)prb[1] * 10000ull / (prb[2] ? prb[2] : 1u));
        if (FX_PROBE == 4) ticks = prb[3] / 10;
        if (FX_PROBE == 20) ticks = (unsigned)((unsigned long long)prb[4] / (prb[5] ? prb[5] : 1u));
        if (FX_PROBE == 7 || FX_PROBE == 8) ticks = (unsigned)((unsigned long long)prb[4] / (prb[5] ? prb[5] : 1u));
        if (FX_PROBE == 5) ticks = (unsigned)((unsigned long long)prb[4] * 10ull / (prb[5] ? prb[5] : 1u));
        if (FX_PROBE == 9) ticks = (unsigned)(((unsigned long long)prb[4] + prb[6]) * 10000ull / (prb[2] ? prb[2] : 1u));
        if (FX_PROBE == 6) ticks = (unsigned)((unsigned long long)prb[6] * 10ull / (prb[7] ? prb[7] : 1u));
        if (FX_PROBE >= 10 && FX_PROBE < 20) ticks = prb[8 + FX_PROBE - 10] / 10;
        const unsigned long long r0 = __builtin_amdgcn_s_memrealtime();
        while (__builtin_amdgcn_s_memrealtime() - r0 < (unsigned long long)ticks) __builtin_amdgcn_s_sleep(8);
    }
#endif
}
}

static void fill_params(fx::Params& P, void* const* d_in, void* d_out, void* d_ws) {
    P.x = (const float*)d_in[0]; P.mem = (const float*)d_in[1]; P.pos = (const int*)d_in[2]; P.norm_g = (const float*)d_in[3]; P.w_in = (const float*)d_in[4];
    P.q_norm_g = (const float*)d_in[5]; P.kv_norm_g = (const float*)d_in[6]; P.w_uq = (const float*)d_in[7]; P.w_ukv = (const float*)d_in[8];
    P.qn_g = (const float*)d_in[9]; P.kn_g = (const float*)d_in[10]; P.dqn_g = (const float*)d_in[11]; P.dkn_g = (const float*)d_in[12];
    P.dlam = (const float*)d_in[13]; P.subln_g = (const float*)d_in[14]; P.mem_norm_g = (const float*)d_in[15]; P.w_mem_kv = (const float*)d_in[16];
    P.mqn_g = (const float*)d_in[17]; P.mkn_g = (const float*)d_in[18]; P.w_out = (const float*)d_in[19];
    P.out = (float*)d_out; P.ws = (unsigned char*)d_ws;
}

extern "C" void kernel_launch(void* const* d_in, const int* in_sizes, int n_in, void* d_out, int out_size, void* d_ws, size_t ws_size, hipStream_t stream) {
    static int grid_blocks = 0;
    if (!grid_blocks) {
        if (n_in != 20 || out_size != NTOK * D_MODEL || ws_size < fx::WS_END) { fprintf(stderr, "kernel_launch: unexpected shapes (n_in %d out %d ws %zu)\n", n_in, out_size, ws_size); grid_blocks = -1; return; }
        if (hipFuncSetAttribute((const void*)fx::fwd_kernel, hipFuncAttributeMaxDynamicSharedMemorySize, fx::LDS_BYTES) != hipSuccess) { fprintf(stderr, "kernel_launch: hipFuncSetAttribute failed\n"); grid_blocks = -1; return; }
        int dev = 0, cus = 0, per_cu = 0;
        (void)hipGetDevice(&dev);
        (void)hipDeviceGetAttribute(&cus, hipDeviceAttributeMultiprocessorCount, dev);
        (void)hipOccupancyMaxActiveBlocksPerMultiprocessor(&per_cu, (const void*)fx::fwd_kernel, fx::NTHREADS, fx::LDS_BYTES);
        if (per_cu < 1 || cus < 1) { fprintf(stderr, "kernel_launch: occupancy query says %d blocks/CU on %d CUs\n", per_cu, cus); grid_blocks = -1; return; }
        grid_blocks = cus;
        fprintf(stderr, "kernel_launch: grid %d (cus %d, per_cu %d)\n", grid_blocks, cus, per_cu);
    }
    if (grid_blocks < 0) return;
    fx::Params P{}; fill_params(P, d_in, d_out, d_ws); P.ph_lo = 0; P.ph_hi = 1;
    void* args[] = {&P};
#ifndef FX_NOCG
    const hipError_t e = hipLaunchCooperativeKernel((const void*)fx::fwd_kernel, dim3(grid_blocks), dim3(fx::NTHREADS), args, fx::LDS_BYTES, stream);
#else
    (void)args; hipLaunchKernelGGL(fx::fwd_kernel, dim3(grid_blocks), dim3(fx::NTHREADS), fx::LDS_BYTES, stream, P); const hipError_t e = hipPeekAtLastError();
#endif
    if (e != hipSuccess) fprintf(stderr, "kernel_launch: cooperative launch failed: %s (grid %d)\n", hipGetErrorString(e), grid_blocks);
}
```
